# Optimizing an MI355X kernel written in HIP

```python
import jax, jax.numpy as jnp
from jax import lax
import numpy as np

D_MODEL = 1024
BATCH = 2
SEQ = 8192
DEPTH = 1

D_MIX = D_MODEL
MLA_HEADS = 8
QK_NOPE = 64
QK_ROPE = 32
V_HEAD = 64
Q_LORA = 256
KV_LORA = 128
ROPE_THETA = 10000.0
Q_BLOCK = 128
SG_HEADS = 8
SG_HEAD_DIM = 64
SG_CHUNK = 128
N_EXPERTS = 32
TOP_K = 4
D_EXPERT = D_MODEL
SWIGLU_LIMIT = 7.0
SWIGLU_ALPHA = 1.702
MOE_BLOCK = 128
D_PLE = 256
EPS = 1e-6
IN_COLS = Q_LORA + KV_LORA + QK_ROPE + 2 * SG_HEADS * SG_HEAD_DIM
MLA_WIDTH = MLA_HEADS * V_HEAD
SG_WIDTH = SG_HEADS * SG_HEAD_DIM

kernel_name = "hymba_mla_sgmlp_moe_sandwich_ple"


def rmsnorm(x, g):
    xf = x.astype(jnp.float32)
    y = xf * lax.rsqrt(jnp.mean(xf * xf, axis=-1, keepdims=True) + EPS)
    return (y * g.astype(jnp.float32)).astype(x.dtype)


def rope_tables(positions):
    inv_freq = 1.0 / (ROPE_THETA ** (jnp.arange(0, QK_ROPE, 2, dtype=jnp.float32) / QK_ROPE))
    ang = positions.astype(jnp.float32)[..., None] * inv_freq
    return jnp.cos(ang), jnp.sin(ang)


def apply_rope(x, cos, sin):
    xf = x.astype(jnp.float32)
    half = xf.shape[-1] // 2
    x1, x2 = xf[..., :half], xf[..., half:]
    return jnp.concatenate([x1 * cos - x2 * sin, x2 * cos + x1 * sin], axis=-1).astype(x.dtype)


def mla_attention(c_q, c_kv, k_rope, cos, sin, q_norm_g, w_uq, kv_norm_g, w_ukv):
    B, S, _ = c_q.shape
    q = jnp.einsum('bsr,rhd->bshd', rmsnorm(c_q, q_norm_g), w_uq)
    q = jnp.concatenate([q[..., :QK_NOPE], apply_rope(q[..., QK_NOPE:], cos[:, :, None], sin[:, :, None])], axis=-1)
    kv = jnp.einsum('bsr,rhd->bshd', rmsnorm(c_kv, kv_norm_g), w_ukv)
    k_nope, v = kv[..., :QK_NOPE], kv[..., QK_NOPE:]
    k_r = apply_rope(k_rope, cos, sin)
    k = jnp.concatenate([k_nope, jnp.broadcast_to(k_r[:, :, None], (B, S, MLA_HEADS, QK_ROPE))], axis=-1)
    scale = (QK_NOPE + QK_ROPE) ** -0.5
    nqb = S // Q_BLOCK
    qb = q.reshape(B, nqb, Q_BLOCK, MLA_HEADS, QK_NOPE + QK_ROPE).transpose(1, 0, 2, 3, 4)
    key_pos = jnp.arange(S)

    def query_block(args):
        i, q_blk = args
        s = jnp.einsum('bqhd,bkhd->bhqk', q_blk, k).astype(jnp.float32) * scale
        q_pos = i * Q_BLOCK + jnp.arange(Q_BLOCK)
        s = jnp.where(key_pos[None, :] <= q_pos[:, None], s, -jnp.inf)
        pr = jax.nn.softmax(s, axis=-1).astype(v.dtype)
        return jnp.einsum('bhqk,bkhd->bqhd', pr, v)

    o = lax.map(query_block, (jnp.arange(nqb), qb))
    return o.transpose(1, 0, 2, 3, 4).reshape(B, S, MLA_WIDTH)


def spatial_gating(z, v_norm_g, w_s, b_s):
    B, S, _ = z.shape
    nc = S // SG_CHUNK
    z = jax.nn.gelu(z)
    u, v = jnp.split(z, 2, axis=-1)
    u = u.reshape(B, nc, SG_CHUNK, SG_HEADS, SG_HEAD_DIM)
    v = rmsnorm(v.reshape(B, nc, SG_CHUNK, SG_HEADS, SG_HEAD_DIM), v_norm_g)
    causal = jnp.tril(jnp.ones((SG_CHUNK, SG_CHUNK), dtype=bool))
    w = jnp.where(causal[None], w_s, jnp.zeros_like(w_s))
    vm = jnp.einsum('hts,bnshc->bnthc', w, v) + b_s.T[None, None, :, :, None]
    return (u * vm).reshape(B, S, SG_WIDTH)


def moe(h, w_router, b_router, w_gate_up, b_gate_up, w_down, b_down):
    B, S, D = h.shape
    N = B * S
    xt = h.reshape(N, D)
    logits = (xt @ w_router + b_router).astype(jnp.float32)
    top_val, top_idx = lax.top_k(logits, TOP_K)
    gate = jax.nn.softmax(top_val, axis=-1)
    A = N * TOP_K
    e_flat = top_idx.reshape(A)
    tok_flat = jnp.repeat(jnp.arange(N, dtype=jnp.int32), TOP_K)
    w_flat = gate.reshape(A)
    order = jnp.argsort(e_flat)
    e_sorted, tok_sorted, w_sorted = e_flat[order], tok_flat[order], w_flat[order]
    counts = jnp.zeros((N_EXPERTS,), jnp.int32).at[e_flat].add(1)
    start = jnp.cumsum(counts) - counts
    padded = (counts + MOE_BLOCK - 1) // MOE_BLOCK * MOE_BLOCK
    pad_end = jnp.cumsum(padded)
    pad_start = pad_end - padded
    dest = pad_start[e_sorted] + (jnp.arange(A, dtype=jnp.int32) - start[e_sorted])
    n_blocks = A // MOE_BLOCK + N_EXPERTS
    P = n_blocks * MOE_BLOCK
    row_tok = jnp.zeros((P,), jnp.int32).at[dest].set(tok_sorted)
    row_w = jnp.zeros((P,), jnp.float32).at[dest].set(w_sorted)
    block_start = jnp.arange(n_blocks, dtype=jnp.int32) * MOE_BLOCK
    block_expert = jnp.minimum(jnp.sum(pad_end[None, :] <= block_start[:, None], axis=-1), N_EXPERTS - 1)
    x_rows = xt[row_tok].reshape(n_blocks, MOE_BLOCK, D)

    def expert_block(args):
        e, xb = args
        gu = xb @ w_gate_up[e] + b_gate_up[e]
        g, u = jnp.split(gu, 2, axis=-1)
        g = jnp.minimum(g, SWIGLU_LIMIT)
        u = jnp.clip(u, -SWIGLU_LIMIT, SWIGLU_LIMIT)
        act = (u + 1.0) * (g * jax.nn.sigmoid(SWIGLU_ALPHA * g))
        return act @ w_down[e] + b_down[e]

    y_rows = lax.map(expert_block, (block_expert, x_rows)).reshape(P, D)
    y = jax.ops.segment_sum(y_rows * row_w[:, None].astype(y_rows.dtype), row_tok, num_segments=N)
    return y.reshape(B, S, D)


def setup_inputs(seed: int = 0) -> dict:
    key = jax.random.key(seed)
    ks = jax.random.split(key, 32)
    f32 = jnp.float32

    def nrm(k, shape, scale):
        return jax.random.normal(k, shape, f32) * scale

    def gain(k, shape):
        return 1.0 + 0.05 * jax.random.normal(k, shape, f32)

    L = DEPTH
    return {
        "x": nrm(ks[0], (BATCH, SEQ, D_MODEL), 1.0),
        "p": nrm(ks[1], (DEPTH, BATCH, SEQ, D_PLE), 1.0),
        "positions": jnp.broadcast_to(jnp.arange(SEQ, dtype=jnp.int32), (BATCH, SEQ)),
        "attn_pre_g": gain(ks[2], (L, D_MODEL)),
        "w_in": nrm(ks[3], (L, D_MODEL, IN_COLS), D_MODEL ** -0.5),
        "q_norm_g": gain(ks[4], (L, Q_LORA)),
        "w_uq": nrm(ks[5], (L, Q_LORA, MLA_HEADS, QK_NOPE + QK_ROPE), Q_LORA ** -0.5),
        "kv_norm_g": gain(ks[6], (L, KV_LORA)),
        "w_ukv": nrm(ks[7], (L, KV_LORA, MLA_HEADS, QK_NOPE + V_HEAD), KV_LORA ** -0.5),
        "sg_norm_g": gain(ks[8], (L, SG_HEADS, SG_HEAD_DIM)),
        "w_spatial": nrm(ks[9], (L, SG_HEADS, SG_CHUNK, SG_CHUNK), SG_CHUNK ** -0.5),
        "b_spatial": 1.0 + 0.1 * jax.random.normal(ks[10], (L, SG_HEADS, SG_CHUNK), f32),
        "mla_out_g": gain(ks[11], (L, MLA_WIDTH)),
        "sg_out_g": gain(ks[12], (L, SG_WIDTH)),
        "w_out": nrm(ks[13], (L, D_MIX, D_MODEL), D_MIX ** -0.5),
        "attn_post_g": gain(ks[14], (L, D_MODEL)),
        "ffn_pre_g": gain(ks[15], (L, D_MODEL)),
        "w_router": nrm(ks[16], (L, D_MODEL, N_EXPERTS), D_MODEL ** -0.5),
        "b_router": nrm(ks[17], (L, N_EXPERTS), 0.01),
        "w_gate_up": nrm(ks[18], (L, N_EXPERTS, D_MODEL, 2 * D_EXPERT), D_MODEL ** -0.5),
        "b_gate_up": nrm(ks[19], (L, N_EXPERTS, 2 * D_EXPERT), 0.02),
        "w_down": nrm(ks[20], (L, N_EXPERTS, D_EXPERT, D_MODEL), D_EXPERT ** -0.5),
        "b_down": nrm(ks[21], (L, N_EXPERTS, D_MODEL), 0.02),
        "ffn_post_g": gain(ks[22], (L, D_MODEL)),
        "w_ple_gate": nrm(ks[23], (L, D_MODEL, D_MODEL), D_MODEL ** -0.5),
        "b_ple_gate": nrm(ks[24], (L, D_MODEL), 0.02),
        "w_ple_proj": nrm(ks[25], (L, D_PLE, D_MODEL), D_PLE ** -0.5),
        "ple_norm_g": gain(ks[26], (L, D_MODEL)),
    }


def reference(x, p, positions, attn_pre_g, w_in, q_norm_g, w_uq, kv_norm_g, w_ukv, sg_norm_g, w_spatial,
              b_spatial, mla_out_g, sg_out_g, w_out, attn_post_g, ffn_pre_g, w_router, b_router, w_gate_up,
              b_gate_up, w_down, b_down, ffn_post_g, w_ple_gate, b_ple_gate, w_ple_proj, ple_norm_g):
    cos, sin = rope_tables(positions)
    splits = [Q_LORA, Q_LORA + KV_LORA, Q_LORA + KV_LORA + QK_ROPE]
    for i in range(DEPTH):
        h = rmsnorm(x, attn_pre_g[i])
        z = h @ w_in[i]
        c_q, c_kv, k_rope, z_sg = jnp.split(z, splits, axis=-1)
        o_mla = mla_attention(c_q, c_kv, k_rope, cos, sin, q_norm_g[i], w_uq[i], kv_norm_g[i], w_ukv[i])
        o_sg = spatial_gating(z_sg, sg_norm_g[i], w_spatial[i], b_spatial[i])
        mix = jnp.concatenate([rmsnorm(o_mla, mla_out_g[i]), rmsnorm(o_sg, sg_out_g[i])], axis=-1)
        x = x + rmsnorm(mix @ w_out[i], attn_post_g[i])
        y = moe(rmsnorm(x, ffn_pre_g[i]), w_router[i], b_router[i], w_gate_up[i], b_gate_up[i], w_down[i], b_down[i])
        x = x + rmsnorm(y, ffn_post_g[i])
        g = jax.nn.sigmoid(x @ w_ple_gate[i] + b_ple_gate[i])
        x = x + rmsnorm(g * (p[i] @ w_ple_proj[i]), ple_norm_g[i])
    return x
```

```cpp
#include <hip/hip_runtime.h>
#include <cstdint>
#include <cstdio>

constexpr int DM = 1024, NBATCH = 2, SEQ = 8192, M = NBATCH * SEQ;
constexpr int NH = 8, QK_NOPE = 64, QK_ROPE = 32, DQK = 96, DV = 64, Q_LORA = 256, KV_LORA = 128;
constexpr int SGH = 8, SGD = 64, SGC = 128;
constexpr int NE = 32, TOPK = 4, DE = 1024;
constexpr int DPLE = 256;
constexpr int IN_COLS = 1440;
constexpr float EPS = 1e-6f;

__device__ __forceinline__ float wave_sum(float v) {
#pragma unroll
    for (int o = 1; o < 64; o <<= 1) v += __shfl_xor(v, o);
    return v;
}

#define GAS __attribute__((address_space(1)))
#define LAS __attribute__((address_space(3)))
typedef unsigned short bf16;
typedef unsigned v4u __attribute__((ext_vector_type(4)));
typedef unsigned v2u __attribute__((ext_vector_type(2)));
typedef float f32x4 __attribute__((ext_vector_type(4)));
typedef float f32x2 __attribute__((ext_vector_type(2)));
typedef float f32x16 __attribute__((ext_vector_type(16)));
typedef short bf16x8 __attribute__((ext_vector_type(8)));
typedef short s16x4 __attribute__((ext_vector_type(4)));
typedef GAS unsigned gu32;
#define RLX_AGENT __ATOMIC_RELAXED, __HIP_MEMORY_SCOPE_AGENT
#define LDS_WAIT() asm volatile("s_waitcnt lgkmcnt(0)" ::: "memory")
#define VM_WAIT() asm volatile("s_waitcnt vmcnt(0)" ::: "memory")
__device__ __forceinline__ unsigned f2bf(float f) { unsigned u = __builtin_bit_cast(unsigned, f); return (u + 0x7fffu + ((u >> 16) & 1u)) >> 16; }
__device__ __forceinline__ unsigned pk2(float lo, float hi) { return f2bf(lo) | (f2bf(hi) << 16); }
__device__ __forceinline__ float bf2f(unsigned short b) { return __builtin_bit_cast(float, (unsigned)b << 16); }
__device__ __forceinline__ float bflo(unsigned w) { return __builtin_bit_cast(float, w << 16); }
__device__ __forceinline__ float bfhi(unsigned w) { return __builtin_bit_cast(float, w & 0xffff0000u); }

constexpr int NWAVES = 8;
constexpr int ZLD = 1536;
constexpr int ZC_KV = 256, ZC_KR = 384, ZC_U = 512, ZC_V = 1024;
constexpr int QLD = NH * DQK, KLD = NH * DQK, VLD = NH * DV;
constexpr float C2Q = 0.10206207261596575f * 1.4426950408889634f;

constexpr size_t MiB = 1u << 20;
constexpr size_t WS_CTL = 0, CTL_ZERO_BYTES = 1 * MiB;
constexpr size_t WS_RSTDX = 1 * MiB;
constexpr size_t WS_RSTD1 = WS_RSTDX + 64 * 1024;
constexpr size_t WS_RSTDX1 = WS_RSTD1 + 64 * 1024;
constexpr size_t WS_QPART = 2 * MiB;
constexpr size_t WS_KVPART = WS_QPART + 256 * 1024;
constexpr size_t WS_SSMLA = WS_KVPART + 256 * 1024;
constexpr size_t WS_TPART = 3 * MiB;
constexpr size_t WS_VPART = 4 * MiB;
constexpr size_t WS_ROPE = 5 * MiB;
constexpr size_t WS_TOPI = 7 * MiB;
constexpr size_t WS_TOPW = WS_TOPI + 256 * 1024;
constexpr size_t WS_WIN = 8 * MiB;
constexpr size_t WS_WUQ = 11 * MiB;
constexpr size_t WS_WUKV = WS_WUQ + 384 * 1024;
constexpr size_t WS_WR = WS_WUKV + 256 * 1024;
constexpr size_t WS_WOUT = 12 * MiB;
constexpr size_t WS_WPG = 14 * MiB;
constexpr size_t WS_WPP = 16 * MiB;
constexpr size_t WS_WGU = 17 * MiB;
constexpr size_t WS_WD = 145 * MiB;
constexpr size_t WS_XB = 209 * MiB;
constexpr size_t WS_PB = 241 * MiB;
constexpr size_t WS_Z = 249 * MiB;
constexpr size_t WS_Q = 297 * MiB;
constexpr size_t WS_K = 321 * MiB;
constexpr size_t WS_V = 345 * MiB;
constexpr size_t WS_MIX = 361 * MiB;
constexpr size_t WS_PPB = 393 * MiB;
constexpr size_t WS_TB = 425 * MiB;
constexpr size_t WS_X1B = 457 * MiB;
constexpr size_t WS_XS = 489 * MiB;
constexpr size_t WS_HS = 633 * MiB;
constexpr size_t WS_YS = 777 * MiB;
constexpr size_t WS_X2B = 905 * MiB;
constexpr size_t WS_VB = 937 * MiB;
constexpr size_t WS_END = 969 * MiB;
constexpr size_t WS_RBHIST = 7 * MiB + 512 * 1024;
constexpr size_t WS_TEXP = 7 * MiB + 576 * 1024;
constexpr size_t WS_ROWSLOT = 7 * MiB + 640 * 1024;
constexpr size_t WS_ROWW = 1 * MiB + 256 * 1024;
constexpr size_t WS_RSS = 1 * MiB + 576 * 1024;
constexpr int CW_NTILES = 64;

constexpr int RING_OFF = 0, RING_BYTES = 131072;
constexpr int SCR_BYTES = 8 * 64 * 65 * 4;
constexpr int LDSCTL_OFF = 144 * 1024, MISC_OFF = LDSCTL_OFF + 320;
constexpr int LDS_BYTES = 148480;
static_assert(SCR_BYTES <= LDSCTL_OFF && MISC_OFF + 128 <= LDS_BYTES, "LDS map");


#ifndef SINGLE_LAUNCH
#define SINGLE_LAUNCH 1
#endif
constexpr bool MOE_WEIGHTS = true;
constexpr int FAST_PHASES = 13;
constexpr int CW_BAR = 4096;
#define XB_TMO      128
#define XB_XCNT(j)  (256  + 64 * (j))
#define XB_XSUB(j)  (1280 + 64 * (j))
#define XB_XGEN(j)  (2304 + 64 * (j))
#define XB_TOP      3328
#define XB_TOPGEN   3392
#define XCD_BAR_WORDS 3456
#define XB_SPIN_CAP (1u << 18)

__device__ __forceinline__ unsigned xb_ld(unsigned* p)              { return __hip_atomic_load(p, __ATOMIC_RELAXED, __HIP_MEMORY_SCOPE_AGENT); }
__device__ __forceinline__ unsigned xb_add(unsigned* p, unsigned v) { return __hip_atomic_fetch_add(p, v, __ATOMIC_RELAXED, __HIP_MEMORY_SCOPE_AGENT); }
__device__ __forceinline__ unsigned xb_xcc_id() { return (unsigned)__builtin_amdgcn_s_getreg((3 << 11) | 20) & 0xFu; }
#define XB_SPIN(cond, bar) do { unsigned _sp = 0; while (cond) { __builtin_amdgcn_s_sleep(1); \
    if ((++_sp & 255u) == 0u) { if (xb_ld(&(bar)[XB_TMO])) break; if (_sp > XB_SPIN_CAP) { atomicAdd(&(bar)[XB_TMO], 1u); break; } } } } while (0)

struct XcdBarrier {
    unsigned* bar; unsigned x;
    volatile LAS unsigned* st;
};

__device__ __forceinline__ XcdBarrier xcd_barrier_post(unsigned* bar, volatile LAS unsigned* st) {
    XcdBarrier b; b.bar = bar; b.x = xb_xcc_id(); b.st = st;
    if (threadIdx.x == 0) (void)xb_add(&bar[XB_XCNT(b.x)], 1u);
    return b;
}
__device__ __forceinline__ void xcd_barrier_complete(unsigned* bar, unsigned x, unsigned& nloc, unsigned& nx) {
    const unsigned G = gridDim.x * gridDim.y * gridDim.z;
    unsigned sum, cnt, mine, sp = 0u;
    for (;;) {
        sum = 0u; cnt = 0u; mine = 0u;
#pragma unroll
        for (unsigned j = 0; j < 16; ++j) { const unsigned c = xb_ld(&bar[XB_XCNT(j)]); sum += c; cnt += (c > 0u) ? 1u : 0u; mine = (j == x) ? c : mine; }
        if (sum == G) break;
        __builtin_amdgcn_s_sleep(1);
        if ((++sp & 255u) == 0u) { if (xb_ld(&bar[XB_TMO])) break; if (sp > XB_SPIN_CAP) { atomicAdd(&bar[XB_TMO], 1u); break; } }
    }
    nloc = mine > 0u ? mine : 1u; nx = cnt > 0u ? cnt : 1u;
}

__device__ __forceinline__ void xcd_barrier(const XcdBarrier& b) {
    asm volatile("s_waitcnt vmcnt(0)" ::: "memory");
    __syncthreads();
    if (threadIdx.x == 0) {
        unsigned* bar = b.bar;
        __builtin_amdgcn_s_waitcnt(0);
        unsigned nloc = b.st[0], nx = b.st[1];
        if (nloc == 0u) { xcd_barrier_complete(bar, b.x, nloc, nx); b.st[0] = nloc; b.st[1] = nx; }
        const unsigned old = xb_add(&bar[XB_XSUB(b.x)], 1u);
        const unsigned gen = old / nloc;
        if (old + 1u == (gen + 1u) * nloc) {
            __builtin_amdgcn_fence(__ATOMIC_RELEASE, "agent");
            asm volatile("s_waitcnt vmcnt(0)" ::: "memory");
            const unsigned og = xb_add(&bar[XB_TOP], 1u);
            const unsigned tg = og / nx;
            if (og + 1u == (tg + 1u) * nx) xb_add(&bar[XB_TOPGEN], 1u);
            else XB_SPIN(xb_ld(&bar[XB_TOPGEN]) == tg, bar);
            __builtin_amdgcn_fence(__ATOMIC_ACQUIRE, "agent");
            xb_add(&bar[XB_XGEN(b.x)], 1u);
            asm volatile("s_waitcnt vmcnt(0)" ::: "memory");
        } else {
            XB_SPIN(xb_ld(&bar[XB_XGEN(b.x)]) == gen, bar);
            __builtin_amdgcn_fence(__ATOMIC_ACQUIRE, "agent");
            asm volatile("s_waitcnt vmcnt(0)" ::: "memory");
        }
    }
    __syncthreads();
}

namespace pg8 {
#define PG8_LAS __attribute__((address_space(3)))
typedef unsigned short bf16_t;
typedef short bf16x8 __attribute__((ext_vector_type(8)));
typedef float f32x4 __attribute__((ext_vector_type(4)));
typedef unsigned u32x4 __attribute__((ext_vector_type(4)));
constexpr int BM = 256, BK = 64, HALF = 128, HTB = HALF * BK * 2  , STAGE_BYTES = 8 * HTB, NXCD = 8, WGM = 8;

__host__ __device__ __forceinline__ int lds_byte(int r, int c) { const int st = (r >> 4) * 2 + (c >> 5), rr = r & 15, cc = c & 31, ob = rr * 64 + cc * 2; return st * 1024 + (ob ^ (((ob >> 9) & 1) << 5)); }
__host__ __device__ __forceinline__ void stage_rc(int b, int& R, int& C) { const int st = b / 1024, sb = b % 1024, swz = sb ^ (((sb >> 9) & 1) << 5); R = (st >> 1) * 16 + swz / 64; C = (st & 1) * 32 + (swz % 64) / 2; }
__host__ __device__ __forceinline__ int perm32(int rho) { const int n = rho >> 4, i = rho & 15; return 8 * (i >> 2) + 4 * n + (i & 3); }

struct Unit { int pm, pn; };
struct Gemm { const bf16_t* A; const bf16_t* Bt; int M, N, K, lda, ldb; };

struct StaticOrder {
    int nM, nN, nwg, G, c;
    __host__ __device__ void init(int M, int N, int G_, int c_) { nM = M / BM; nN = N / BM; nwg = nM * nN; G = G_; c = c_; }
    __host__ __device__ bool next(int i, Unit& u) const {
        const long L = (long)i * G + c; if (L >= nwg) return false;
        int wgid = (int)L; { const int q = nwg / NXCD, r = nwg % NXCD, xcd = wgid % NXCD, off = wgid / NXCD; wgid = (xcd < r ? xcd * (q + 1) : r * (q + 1) + (xcd - r) * q) + off; }
        const int nig = WGM * nN, gid = wgid / nig, fm = gid * WGM, gsz = (nM - fm) < WGM ? (nM - fm) : WGM;
        u.pm = fm + ((wgid % nig) % gsz); u.pn = (wgid % nig) / gsz; return true;
    }
    __device__ __forceinline__ void a_ready(const Unit&) const {}
    __device__ __forceinline__ void done(const Unit&) const {}
};

__device__ __forceinline__ unsigned cvt_pk_bf16(float lo, float hi) { unsigned r; asm volatile("v_cvt_pk_bf16_f32 %0, %1, %2" : "=v"(r) : "v"(lo), "v"(hi)); return r; }
template <class Epi, class Sched, bool ALIGN_EPI = false, bool SP2 = false>
__device__ __forceinline__ void gemm_phase(PG8_LAS unsigned char* lds, const Gemm g, const Sched& S, const Epi& E) {
    int tid_ = threadIdx.x; asm volatile("" : "+v"(tid_));
    const int tid = tid_, wid = __builtin_amdgcn_readfirstlane(tid >> 6), lane = tid & 63, wr = wid >> 2, wc = wid & 3, fr = lane & 15, fq = lane >> 4;
    int K_ = g.K; asm volatile("" : "+s"(K_));
    const int K = K_, nt = K / BK;
    unsigned voffA[2], voffB[2];
#pragma unroll
    for (int i = 0; i < 2; ++i) { int R, C; stage_rc(tid * 16 + i * 8192, R, C); const int Rb = Epi::PERM ? ((R & ~31) + perm32(R & 31)) : R;
        voffA[i] = (unsigned)(R * g.lda + C) * 2u; voffB[i] = (unsigned)(Rb * g.ldb + C) * 2u; }
    const size_t kstep = (size_t)(BK * 2);
    const size_t hstepA = (size_t)HALF * g.lda * 2, hstepB = (size_t)HALF * g.ldb * 2;
    const size_t tstepA = 2 * hstepA, tstepB = 2 * hstepB;
    const unsigned ldsw = (unsigned)wid * 1024u;
    const int aoff = lds_byte(wr * 64 + fr, fq * 8), boff = lds_byte(wc * 32 + fr, fq * 8);
#define PG8_SA(b, h) (((b) * 2 + (h)) * HTB)
#define PG8_SB(b, h) ((4 + (b) * 2 + (h)) * HTB)
#define PG8_STAGE(bufoff, gbase, voff) do { _Pragma("unroll") for (int _i = 0; _i < 2; ++_i) \
        __builtin_amdgcn_global_load_lds((const unsigned*)((const char*)(gbase) + (voff)[_i]), (PG8_LAS unsigned*)(lds + (bufoff) + ldsw + _i * 8192), 16, 0, 0); } while (0)
#define PG8_LDA(dst, b, h) do { _Pragma("unroll") for (int m = 0; m < 4; ++m) _Pragma("unroll") for (int k = 0; k < 2; ++k) dst[m][k] = *(const PG8_LAS bf16x8*)(lds + PG8_SA(b, h) + aoff + m * 2048 + k * 1024); } while (0)
#define PG8_LDB(dst, b, h) do { _Pragma("unroll") for (int n = 0; n < 2; ++n) _Pragma("unroll") for (int k = 0; k < 2; ++k) dst[n][k] = *(const PG8_LAS bf16x8*)(lds + PG8_SB(b, h) + boff + n * 2048 + k * 1024); } while (0)
#define PG8_MMA(ai, bj, At, Bt) do { __builtin_amdgcn_s_setprio(1); _Pragma("unroll") for (int m = 0; m < 4; ++m) _Pragma("unroll") for (int n = 0; n < 2; ++n) _Pragma("unroll") for (int k = 0; k < 2; ++k) \
        acc[ai][bj][m][n] = __builtin_amdgcn_mfma_f32_16x16x32_bf16(Bt[n][k], At[m][k], acc[ai][bj][m][n], 0, 0, 0); __builtin_amdgcn_s_setprio(0); } while (0)
#define PG8_WAIT_V(n) asm volatile("s_waitcnt vmcnt(" #n ")" ::: "memory")
#define PG8_WAIT_L(n) asm volatile("s_waitcnt lgkmcnt(" #n ")" ::: "memory")
#define PG8_BAR __builtin_amdgcn_s_barrier()
#define PG8_SCHED __builtin_amdgcn_sched_barrier(0)
    Unit cur, nxt; int ui = 0;
    if (!S.next(0, cur)) return;
    f32x4 acc[2][2][4][2];
#pragma unroll
    for (int a = 0; a < 2; ++a)
#pragma unroll
        for (int b = 0; b < 2; ++b)
#pragma unroll
            for (int m = 0; m < 4; ++m)
#pragma unroll
                for (int n = 0; n < 2; ++n) acc[a][b][m][n] = (f32x4){0.f, 0.f, 0.f, 0.f};
    bf16x8 At[4][2], B0[2][2], B1[2][2];
    const char* cA = (const char*)g.A + (size_t)cur.pm * tstepA; const char* cB = (const char*)g.Bt + (size_t)cur.pn * tstepB;
    S.a_ready(cur);
    if constexpr (SP2) {
        PG8_STAGE(PG8_SB(0, 0), cB, voffB); PG8_STAGE(PG8_SB(0, 1), cB + hstepB, voffB); PG8_STAGE(PG8_SA(0, 0), cA, voffA); PG8_STAGE(PG8_SA(0, 1), cA + hstepA, voffA);
        if (wr == 1) PG8_BAR;
        PG8_WAIT_V(2); PG8_BAR;
        PG8_STAGE(PG8_SB(1, 0), cB + kstep, voffB); PG8_STAGE(PG8_SA(1, 0), cA + kstep, voffA); PG8_STAGE(PG8_SB(1, 1), cB + hstepB + kstep, voffB);
        PG8_WAIT_V(6); PG8_BAR;
    } else {
        PG8_STAGE(PG8_SB(0, 0), cB, voffB); PG8_STAGE(PG8_SA(0, 0), cA, voffA); PG8_STAGE(PG8_SB(0, 1), cB + hstepB, voffB); PG8_STAGE(PG8_SA(0, 1), cA + hstepA, voffA);
        if (wr == 1) PG8_BAR;
        PG8_WAIT_V(4); PG8_BAR;
        PG8_STAGE(PG8_SB(1, 0), cB + kstep, voffB); PG8_STAGE(PG8_SA(1, 0), cA + kstep, voffA); PG8_STAGE(PG8_SB(1, 1), cB + hstepB + kstep, voffB);
        PG8_WAIT_V(6); PG8_BAR;
    }
    for (;;) {
        const bool has_next = S.next(ui + 1, nxt);
        const char* nA = has_next ? (const char*)g.A + (size_t)nxt.pm * tstepA : cA; const char* nB = has_next ? (const char*)g.Bt + (size_t)nxt.pn * tstepB : cB;
        for (int t = 0; t < nt; t += 2) {
            const bool last = (t == nt - 2);
            const char* a1 = cA + (size_t)(t + 1) * kstep;
            const char* a2 = last ? nA : cA + (size_t)(t + 2) * kstep; const char* b2 = last ? nB : cB + (size_t)(t + 2) * kstep;
            const char* a3 = a2 + kstep; const char* b3 = b2 + kstep;
            if (last && has_next) S.a_ready(nxt);
            if constexpr (SP2) {
            PG8_LDB(B0, 0, 0); PG8_LDB(B1, 0, 1); PG8_SCHED; PG8_LDA(At, 0, 0); PG8_STAGE(PG8_SA(1, 1), a1 + hstepA, voffA);
            PG8_WAIT_V(8); PG8_WAIT_L(0); PG8_BAR; PG8_MMA(0, 0, At, B0); PG8_MMA(0, 1, At, B1); PG8_BAR; PG8_SCHED;
            PG8_LDA(At, 0, 1); PG8_STAGE(PG8_SB(0, 0), b2, voffB); PG8_STAGE(PG8_SB(0, 1), b2 + hstepB, voffB); PG8_STAGE(PG8_SA(0, 0), a2, voffA);
            PG8_WAIT_V(8); PG8_WAIT_L(0); PG8_BAR; PG8_MMA(1, 0, At, B0); PG8_MMA(1, 1, At, B1); PG8_BAR; PG8_SCHED;
            PG8_LDB(B0, 1, 0); PG8_LDB(B1, 1, 1); PG8_SCHED; PG8_LDA(At, 1, 0); PG8_STAGE(PG8_SA(0, 1), a2 + hstepA, voffA);
            PG8_WAIT_V(8); PG8_WAIT_L(0); PG8_BAR; PG8_MMA(0, 0, At, B0); PG8_MMA(0, 1, At, B1); PG8_BAR; PG8_SCHED;
            PG8_LDA(At, 1, 1); PG8_STAGE(PG8_SB(1, 0), b3, voffB); PG8_STAGE(PG8_SB(1, 1), b3 + hstepB, voffB); PG8_STAGE(PG8_SA(1, 0), a3, voffA);
            PG8_WAIT_V(8); PG8_WAIT_L(0); PG8_BAR; PG8_MMA(1, 0, At, B0); PG8_MMA(1, 1, At, B1); PG8_BAR; PG8_SCHED;
            } else {
            PG8_LDB(B0, 0, 0); PG8_SCHED; PG8_LDA(At, 0, 0); PG8_STAGE(PG8_SA(1, 1), a1 + hstepA, voffA);
            PG8_WAIT_L(8); PG8_BAR; PG8_WAIT_L(0); PG8_MMA(0, 0, At, B0); PG8_BAR; PG8_SCHED;
            PG8_LDB(B1, 0, 1); PG8_STAGE(PG8_SB(0, 0), b2, voffB);
            PG8_BAR; PG8_WAIT_L(0); PG8_MMA(0, 1, At, B1); PG8_BAR;
            PG8_LDA(At, 0, 1); PG8_STAGE(PG8_SA(0, 0), a2, voffA);
            PG8_BAR; PG8_WAIT_L(0); PG8_MMA(1, 0, At, B0); PG8_BAR; PG8_SCHED;
            PG8_STAGE(PG8_SB(0, 1), b2 + hstepB, voffB);
            PG8_WAIT_V(6); PG8_BAR; PG8_MMA(1, 1, At, B1); PG8_BAR;
            PG8_LDB(B0, 1, 0); PG8_SCHED; PG8_LDA(At, 1, 0); PG8_STAGE(PG8_SA(0, 1), a2 + hstepA, voffA);
            PG8_WAIT_L(8); PG8_BAR; PG8_WAIT_L(0); PG8_MMA(0, 0, At, B0); PG8_BAR; PG8_SCHED;
            PG8_LDB(B1, 1, 1); PG8_STAGE(PG8_SB(1, 0), b3, voffB);
            PG8_BAR; PG8_WAIT_L(0); PG8_MMA(0, 1, At, B1); PG8_BAR;
            PG8_LDA(At, 1, 1); PG8_STAGE(PG8_SA(1, 0), a3, voffA);
            PG8_BAR; PG8_WAIT_L(0); PG8_MMA(1, 0, At, B0); PG8_BAR; PG8_SCHED;
            PG8_STAGE(PG8_SB(1, 1), b3 + hstepB, voffB);
            PG8_WAIT_V(6); PG8_BAR; PG8_MMA(1, 1, At, B1); PG8_BAR;
            }
        }
        if constexpr (ALIGN_EPI) { if (wr == 0) PG8_BAR; }
        if constexpr (!Epi::AFTER_DRAIN) { E(acc, cur, wr, wc, fr, fq); S.done(cur); }
        if (!has_next) break;
#pragma unroll
        for (int a = 0; a < 2; ++a)
#pragma unroll
            for (int b = 0; b < 2; ++b)
#pragma unroll
                for (int m = 0; m < 4; ++m)
#pragma unroll
                    for (int n = 0; n < 2; ++n) acc[a][b][m][n] = (f32x4){0.f, 0.f, 0.f, 0.f};
        cur = nxt; cA = nA; cB = nB; ++ui;
        if constexpr (ALIGN_EPI) { if (wr == 1) PG8_BAR; }
    }
    PG8_WAIT_V(0);
    if constexpr (!ALIGN_EPI) { if (wr == 0) PG8_BAR; }
    PG8_BAR;
    if constexpr (Epi::AFTER_DRAIN) { E.fused(acc, cur, wr, wc, fr, fq, lds, wid, lane); S.done(cur); }
#undef PG8_SA
#undef PG8_SB
#undef PG8_STAGE
#undef PG8_LDA
#undef PG8_LDB
#undef PG8_MMA
#undef PG8_WAIT_V
#undef PG8_WAIT_L
#undef PG8_BAR
#undef PG8_SCHED
}
}


template <int MAP> __device__ __forceinline__ int conv_map(int n) {
    if (MAP == 1) return n >= 416 ? n + 96 : n;
    if (MAP == 2) { const int j = n & 1023; return 32 * (j >> 4) + (j & 15) + ((n >> 10) << 4); }
    return n;
}
template <int MAP> __device__ __forceinline__ void conv_item(const float* W, int ldsrc, int N, int k0, int n0, bf16* dst, int ldd, const float* gain, int glim,
                                                             LAS float* scr, int lane) {
    const int kr = lane >> 4, nc = (lane & 15) * 4;
    f32x4 v[16];
#pragma unroll
    for (int i = 0; i < 16; ++i) {
        const int kk = 4 * i + kr;
        if (n0 + nc < N) v[i] = *(const GAS f32x4*)(W + (size_t)(k0 + kk) * ldsrc + n0 + nc); else v[i] = (f32x4){0.f, 0.f, 0.f, 0.f};
    }
#pragma unroll
    for (int i = 0; i < 16; ++i) {
        const int kk = 4 * i + kr;
        float gs = 1.f; if (gain && (k0 + kk) < glim) gs = gain[k0 + kk];
        LAS float* s = scr + kk * 65 + nc;
        s[0] = v[i].x * gs; s[1] = v[i].y * gs; s[2] = v[i].z * gs; s[3] = v[i].w * gs;
    }
    LDS_WAIT(); asm volatile("" ::: "memory");
    const int c = lane & 7;
#pragma unroll
    for (int j = 0; j < 8; ++j) {
        const int n = (lane >> 3) + 8 * j; const LAS float* s = scr + (8 * c) * 65 + n;
        v4u o; o.x = pk2(s[0 * 65], s[1 * 65]); o.y = pk2(s[2 * 65], s[3 * 65]); o.z = pk2(s[4 * 65], s[5 * 65]); o.w = pk2(s[6 * 65], s[7 * 65]);
        if (n0 + n < N) *(GAS v4u*)(dst + (size_t)conv_map<MAP>(n0 + n) * ldd + k0 + 8 * c) = o;
    }
    LDS_WAIT(); asm volatile("" ::: "memory");
}

struct Args { const float* in[28]; float* out; unsigned char* ws; int ph_lo, ph_hi; };
struct Frame {
    LAS unsigned char* lds;
    volatile LAS unsigned* MISC;
    gu32* ctl;
    int tid, lane, wave;
    int vcu, G;
    unsigned char* ws;
    float* out;
};

template <bool MOE_W> __device__ __forceinline__ void p0_prologue(Frame& F, const Args& A) {
    LAS float* scr = (LAS float*)(F.lds) + F.wave * (64 * 65);
    const int gw = F.vcu * NWAVES + F.wave, NGW = F.G * NWAVES;
    unsigned char* ws = F.ws;
    constexpr int I_IN = 16 * 23, I_UQ = 4 * 12, I_UKV = 2 * 16, I_R = 16, I_OUT = 256, I_PG = 256, I_PP = 4 * 16;
    constexpr int I_GU = 32 * 16 * 32, I_D = 32 * 16 * 16;
    constexpr int NSMALL = I_IN + I_UQ + I_UKV + I_R + I_OUT + I_PG + I_PP;
    constexpr int NITEMS = NSMALL + (MOE_W ? I_GU + I_D : 0);
    for (int it = gw; it < NITEMS; it += NGW) {
        int r = it;
        if (MOE_W) {
            if (r < I_GU) { const int e = r >> 9, rr = r & 511, kb = rr >> 5, nb = rr & 31;
                conv_item<2>(A.in[19] + (size_t)e * DM * 2048, 2048, 2048, kb * 64, nb * 64, (bf16*)(ws + WS_WGU) + (size_t)e * 2048 * 1024, 1024, A.in[16], 1024, scr, F.lane); continue; }
            r -= I_GU;
            if (r < I_D) { const int e = r >> 8, rr = r & 255, kb = rr >> 4, nb = rr & 15;
                conv_item<0>(A.in[21] + (size_t)e * DE * DM, 1024, 1024, kb * 64, nb * 64, (bf16*)(ws + WS_WD) + (size_t)e * 1024 * 1024, 1024, nullptr, 0, scr, F.lane); continue; }
            r -= I_D;
        }
        if (r < I_IN) { conv_item<1>(A.in[4], IN_COLS, IN_COLS, (r / 23) * 64, (r % 23) * 64, (bf16*)(ws + WS_WIN), 1024, A.in[3], 1024, scr, F.lane); continue; } r -= I_IN;
        if (r < I_UQ) { conv_item<0>(A.in[6], 768, 768, (r / 12) * 64, (r % 12) * 64, (bf16*)(ws + WS_WUQ), 256, A.in[5], 256, scr, F.lane); continue; } r -= I_UQ;
        if (r < I_UKV) { conv_item<0>(A.in[8], 1024, 1024, (r / 16) * 64, (r % 16) * 64, (bf16*)(ws + WS_WUKV), 128, A.in[7], 128, scr, F.lane); continue; } r -= I_UKV;
        if (r < I_R) { conv_item<0>(A.in[17], 32, 32, r * 64, 0, (bf16*)(ws + WS_WR), 1024, A.in[16], 1024, scr, F.lane); continue; } r -= I_R;
        if (r < I_OUT) { conv_item<0>(A.in[14], 1024, 1024, (r >> 4) * 64, (r & 15) * 64, (bf16*)(ws + WS_WOUT), 1024, A.in[12], 512, scr, F.lane); continue; } r -= I_OUT;
        if (r < I_PG) { conv_item<0>(A.in[24], 1024, 1024, (r >> 4) * 64, (r & 15) * 64, (bf16*)(ws + WS_WPG), 1024, nullptr, 0, scr, F.lane); continue; } r -= I_PG;
        conv_item<0>(A.in[26], 1024, 1024, (r >> 4) * 64, (r & 15) * 64, (bf16*)(ws + WS_WPP), 256, nullptr, 0, scr, F.lane);
    }
    const float* x = A.in[0]; const float* p = A.in[1]; const int* pos = (const int*)A.in[2];
    bf16* xb = (bf16*)(ws + WS_XB); bf16* pb = (bf16*)(ws + WS_PB); float* rstdx = (float*)(ws + WS_RSTDX); f32x2* rope = (f32x2*)(ws + WS_ROPE);
    for (int m = gw; m < M; m += NGW) {
        const GAS f32x4* xr = (const GAS f32x4*)(x + (size_t)m * DM) + F.lane;
        f32x4 v[4]; float s = 0.f;
#pragma unroll
        for (int j = 0; j < 4; ++j) { v[j] = xr[64 * j]; s += (v[j].x * v[j].x + v[j].y * v[j].y) + (v[j].z * v[j].z + v[j].w * v[j].w); }
        s = wave_sum(s);
        GAS v2u* o8 = (GAS v2u*)(xb + (size_t)m * DM) + F.lane;
#pragma unroll
        for (int j = 0; j < 4; ++j) { v2u w; w.x = pk2(v[j].x, v[j].y); w.y = pk2(v[j].z, v[j].w); o8[64 * j] = w; }
        const f32x4 pv = *((const GAS f32x4*)(p + (size_t)m * DPLE) + F.lane);
        { v2u w; w.x = pk2(pv.x, pv.y); w.y = pk2(pv.z, pv.w); *((GAS v2u*)(pb + (size_t)m * DPLE) + F.lane) = w; }
        if (F.lane == 0) rstdx[m] = rsqrtf(s * (1.f / DM) + EPS);
        if (F.lane < 16) {
            const float inv_freq = 1.0f / powf(10000.0f, (float)(2 * F.lane) / 32.0f);
            const float ang = (float)pos[m] * inv_freq;
            rope[(size_t)m * 16 + F.lane] = (f32x2){cosf(ang), sinf(ang)};
        }
    }
}

namespace pg8 {
struct EpiZ {
    static constexpr bool PERM = true, AFTER_DRAIN = false;
    bf16_t* Z; const float* rstdx; float* qpart; float* kvpart;
    __device__ __forceinline__ void operator()(const f32x4 (&acc)[2][2][4][2], const Unit& u, int wr, int wc, int fr, int fq) const {
        const int row0 = u.pm * BM + wr * 64 + fr, col0 = u.pn * BM + wc * 32 + 8 * fq;
#pragma unroll
        for (int ai = 0; ai < 2; ++ai)
#pragma unroll
            for (int m = 0; m < 4; ++m) {
                const int row = row0 + ai * HALF + m * 16; const float rs = rstdx[row]; float ss[2];
#pragma unroll
                for (int bj = 0; bj < 2; ++bj) {
                    const f32x4 v0 = acc[ai][bj][m][0] * rs, v1 = acc[ai][bj][m][1] * rs;
                    u32x4 w; w.x = cvt_pk_bf16(v0[0], v0[1]); w.y = cvt_pk_bf16(v0[2], v0[3]); w.z = cvt_pk_bf16(v1[0], v1[1]); w.w = cvt_pk_bf16(v1[2], v1[3]);
                    *(u32x4*)(Z + (size_t)row * 1536 + col0 + bj * HALF) = w;
                    ss[bj] = (v0[0] * v0[0] + v0[1] * v0[1]) + (v0[2] * v0[2] + v0[3] * v0[3]) + (v1[0] * v1[0] + v1[1] * v1[1]) + (v1[2] * v1[2] + v1[3] * v1[3]);
                }
                if (u.pn < 2) {
                    float s = (u.pn == 0) ? ss[0] + ss[1] : ss[0];
                    s += __shfl_xor(s, 16); s += __shfl_xor(s, 32);
                    if (fq == 0) { float* dst = (u.pn == 0) ? qpart : kvpart; dst[row * 4 + wc] = s; }
                }
            }
    }
};
struct EpiQ {
    static constexpr bool PERM = false, AFTER_DRAIN = false;
    bf16_t* Q; const float* qpart; const f32x2* rope;
    __device__ __forceinline__ void operator()(const f32x4 (&acc)[2][2][4][2], const Unit& u, int wr, int wc, int fr, int fq) const {
        const int row0 = u.pm * BM + wr * 64 + fr;
#pragma unroll
        for (int ai = 0; ai < 2; ++ai)
#pragma unroll
            for (int m = 0; m < 4; ++m) {
                const int row = row0 + ai * HALF + m * 16;
                const f32x4 qp = *(const f32x4*)(qpart + row * 4);
                const float rs = rsqrtf(((qp[0] + qp[1]) + (qp[2] + qp[3])) * (1.f / 256.f) + EPS) * C2Q;
#pragma unroll
                for (int bj = 0; bj < 2; ++bj) {
                    const int gb = u.pn * BM + bj * HALF + wc * 32;
                    f32x4 a = acc[ai][bj][m][0] * rs, b = acc[ai][bj][m][1] * rs;
                    if ((gb >> 5) % 3 == 2) {
                        const f32x2* cs = rope + (size_t)row * 16 + 4 * fq;
                        f32x4 oa, ob;
#pragma unroll
                        for (int i = 0; i < 4; ++i) { const f32x2 c = cs[i]; oa[i] = a[i] * c.x - b[i] * c.y; ob[i] = b[i] * c.x + a[i] * c.y; }
                        a = oa; b = ob;
                    }
                    v2u w0, w1; w0.x = cvt_pk_bf16(a[0], a[1]); w0.y = cvt_pk_bf16(a[2], a[3]); w1.x = cvt_pk_bf16(b[0], b[1]); w1.y = cvt_pk_bf16(b[2], b[3]);
                    *(v2u*)(Q + (size_t)row * 768 + gb + 4 * fq) = w0;
                    *(v2u*)(Q + (size_t)row * 768 + gb + 16 + 4 * fq) = w1;
                }
                asm volatile("" ::: "memory");
            }
    }
};
struct EpiKV {
    static constexpr bool PERM = true, AFTER_DRAIN = false;
    bf16_t* Kb; bf16_t* Vb; const float* kvpart;
    __device__ __forceinline__ void operator()(const f32x4 (&acc)[2][2][4][2], const Unit& u, int wr, int wc, int fr, int fq) const {
        const int row0 = u.pm * BM + wr * 64 + fr, d = wc * 32 + 8 * fq;
#pragma unroll
        for (int ai = 0; ai < 2; ++ai)
#pragma unroll
            for (int m = 0; m < 4; ++m) {
                const int row = row0 + ai * HALF + m * 16;
                const f32x4 qp = *(const f32x4*)(kvpart + row * 4);
                const float rs = rsqrtf(((qp[0] + qp[1]) + (qp[2] + qp[3])) * (1.f / 128.f) + EPS);
#pragma unroll
                for (int bj = 0; bj < 2; ++bj) {
                    const int h = 2 * u.pn + bj;
                    const f32x4 v0 = acc[ai][bj][m][0] * rs, v1 = acc[ai][bj][m][1] * rs;
                    u32x4 w; w.x = cvt_pk_bf16(v0[0], v0[1]); w.y = cvt_pk_bf16(v0[2], v0[3]); w.z = cvt_pk_bf16(v1[0], v1[1]); w.w = cvt_pk_bf16(v1[2], v1[3]);
                    bf16_t* dst = (d < 64) ? Kb + (size_t)row * 768 + h * 96 + d : Vb + (size_t)row * 512 + h * 64 + (d - 64);
                    *(u32x4*)dst = w;
                }
                asm volatile("" ::: "memory");
            }
    }
};
struct EpiStore {
    static constexpr bool PERM = true, AFTER_DRAIN = false;
    bf16_t* O; int ldc; const float* rowscale;
    __device__ __forceinline__ void operator()(const f32x4 (&acc)[2][2][4][2], const Unit& u, int wr, int wc, int fr, int fq) const {
        const int row0 = u.pm * BM + wr * 64 + fr, col0 = u.pn * BM + wc * 32 + 8 * fq;
#pragma unroll
        for (int ai = 0; ai < 2; ++ai)
#pragma unroll
            for (int m = 0; m < 4; ++m) {
                const int row = row0 + ai * HALF + m * 16; const float rs = rowscale ? rowscale[row] : 1.f;
#pragma unroll
                for (int bj = 0; bj < 2; ++bj) {
                    const f32x4 v0 = acc[ai][bj][m][0] * rs, v1 = acc[ai][bj][m][1] * rs;
                    u32x4 w; w.x = cvt_pk_bf16(v0[0], v0[1]); w.y = cvt_pk_bf16(v0[2], v0[3]); w.z = cvt_pk_bf16(v1[0], v1[1]); w.w = cvt_pk_bf16(v1[2], v1[3]);
                    *(u32x4*)(O + (size_t)row * ldc + col0 + bj * HALF) = w;
                }
            }
    }
};
}

__device__ __forceinline__ void p2_krope(Frame& F) {
    const int gw = F.vcu * NWAVES + F.wave, NGW = F.G * NWAVES;
    const bf16* z = (const bf16*)(F.ws + WS_Z); bf16* Kb = (bf16*)(F.ws + WS_K); const f32x2* rope = (const f32x2*)(F.ws + WS_ROPE);
    for (int m0 = gw * 4; m0 < M; m0 += NGW * 4) {
        const int row = m0 + (F.lane >> 4), j = F.lane & 15;
        const float x1 = bf2f(z[(size_t)row * ZLD + ZC_KR + j]), x2 = bf2f(z[(size_t)row * ZLD + ZC_KR + 16 + j]);
        const f32x2 c = rope[(size_t)row * 16 + j];
        const bf16 o1 = (bf16)f2bf(x1 * c.x - x2 * c.y), o2 = (bf16)f2bf(x2 * c.x + x1 * c.y);
#pragma unroll
        for (int h = 0; h < NH; ++h) { Kb[(size_t)row * KLD + h * DQK + 64 + j] = o1; Kb[(size_t)row * KLD + h * DQK + 80 + j] = o2; }
    }
}

namespace att {
constexpr int NW = 8, QBLK = 32, KVBLK = 64, QB = NW * QBLK;
constexpr int SHM_V = KVBLK * DV * 2;
constexpr int SHM_K = KVBLK * 256;
constexpr int LDS_BYTES_ATT = 2 * SHM_V + 2 * SHM_K + NW * 64 * 4;
#define KSWZ(row, colB) ((row) * 256 + ((colB) ^ (((row) & 7) << 4)))
#define SBAR() __builtin_amdgcn_sched_barrier(0)
__device__ __forceinline__ int v_st(int k, int c) { const int kk = (k & ~0xC) | ((k & 4) << 1) | ((k & 8) >> 1); return ((kk >> 3) * 2 + (c >> 5)) * 512 + ((kk & 7) * 32 + (c & 31)) * 2; }
__device__ __forceinline__ int v_rd_base(int lane) { return ((lane & 3) << 3) | (((lane >> 2) & 3) << 6) | (((lane >> 4) & 1) << 5) | (((lane >> 5) & 1) << 8); }
__device__ __forceinline__ int crow(int r, int hi) { return (r & 3) + 8 * (r >> 2) + 4 * hi; }
__device__ __forceinline__ unsigned cvtpk(float lo, float hi) { unsigned r; asm volatile("v_cvt_pk_bf16_f32 %0, %1, %2" : "=v"(r) : "v"(lo), "v"(hi)); return r; }

__device__ __forceinline__ void mask_tile(f32x16& p0, f32x16& p1, int dq) {
    const float NEG = -__builtin_inff();
#pragma unroll
    for (int r = 0; r < 16; ++r) {
        const int c = (r & 3) + 8 * (r >> 2);
        if (dq - c < 0) p0[r] = NEG;
        if (dq - c - 32 < 0) p1[r] = NEG;
    }
}
constexpr float THRL = 8.f;
__device__ __forceinline__ void partialSM(f32x16& p0, f32x16& p1, float& m_reg, float& alpha) {
    float pmax = p0[0];
#pragma unroll
    for (int r = 1; r < 16; ++r) pmax = fmaxf(pmax, p0[r]);
#pragma unroll
    for (int r = 0; r < 16; ++r) pmax = fmaxf(pmax, p1[r]);
    { auto rr = __builtin_amdgcn_permlane32_swap(__float_as_uint(pmax), __float_as_uint(pmax), false, false);
      pmax = fmaxf(__uint_as_float(rr[0]), __uint_as_float(rr[1])); }
    float mn;
    if (__builtin_expect(__all((pmax - m_reg) <= THRL), 1)) { mn = m_reg; alpha = 1.f; }
    else { mn = fmaxf(m_reg, pmax); alpha = __builtin_amdgcn_exp2f(m_reg - mn); m_reg = mn; }
#pragma unroll
    for (int r = 0; r < 16; ++r) p0[r] = p0[r] - mn;
#pragma unroll
    for (int r = 0; r < 16; ++r) p1[r] = p1[r] - mn;
#pragma unroll
    for (int r = 0; r < 16; ++r) p0[r] = __builtin_amdgcn_exp2f(p0[r]);
}
__device__ __forceinline__ void finishSM(f32x16& p0, f32x16& p1, float alpha, float& l_reg, bf16x8& pa0, bf16x8& pa1, bf16x8& pa2, bf16x8& pa3) {
#pragma unroll
    for (int r = 0; r < 16; ++r) p1[r] = __builtin_amdgcn_exp2f(p1[r]);
    float ps = 0;
#pragma unroll
    for (int r = 0; r < 16; ++r) ps += p0[r];
#pragma unroll
    for (int r = 0; r < 16; ++r) ps += p1[r];
    { auto rr = __builtin_amdgcn_permlane32_swap(__float_as_uint(ps), __float_as_uint(ps), false, false);
      ps = __uint_as_float(rr[0]) + __uint_as_float(rr[1]); }
    l_reg = l_reg * alpha + ps;
#define PK4(P, B_, OUT) do { unsigned a0 = cvtpk(P[B_+0], P[B_+1]), a1 = cvtpk(P[B_+2], P[B_+3]);                          \
        unsigned b0 = cvtpk(P[B_+4], P[B_+5]), b1 = cvtpk(P[B_+6], P[B_+7]);                                             \
        auto r0 = __builtin_amdgcn_permlane32_swap(a0, b0, false, false); auto r1 = __builtin_amdgcn_permlane32_swap(a1, b1, false, false); \
        v4u w = {r0[0], r1[0], r0[1], r1[1]}; OUT = __builtin_bit_cast(bf16x8, w); } while (0)
    PK4(p0, 0, pa0); PK4(p0, 8, pa1); PK4(p1, 0, pa2); PK4(p1, 8, pa3);
#undef PK4
}
template <int KB>
__device__ __forceinline__ void qkt(f32x16& p0, f32x16& p1, const char* K_lds, int r32, int hi, const bf16x8* qr) {
    p0 = f32x16{}; p1 = f32x16{};
    const char* kb[2];
#pragma unroll
    for (int dd = 0; dd < 2; ++dd) kb[dd] = K_lds + KB * SHM_K + KSWZ(r32, (dd * 16 + hi * 8) * 2);
    const char* kb2[2];
#pragma unroll
    for (int dd = 0; dd < 2; ++dd) kb2[dd] = K_lds + KB * SHM_K + KSWZ(r32, ((dd + 2) * 16 + hi * 8) * 2);
#pragma unroll
    for (int d0 = 0; d0 < 6; ++d0) {
        const char* a = (d0 & 2) ? kb2[d0 & 1] + (d0 >> 2) * 128 : kb[d0 & 1] + (d0 >> 2) * 128;
        bf16x8 b0 = *reinterpret_cast<const bf16x8*>(a);
        bf16x8 b1 = *reinterpret_cast<const bf16x8*>(a + 32 * 256);
        p0 = __builtin_amdgcn_mfma_f32_32x32x16_bf16(b0, qr[d0], p0, 0, 0, 0);
        p1 = __builtin_amdgcn_mfma_f32_32x32x16_bf16(b1, qr[d0], p1, 0, 0, 0);
    }
}
template <int VB>
__device__ __forceinline__ void pv_tile(f32x16* o, int vb0, bf16x8 pa0, bf16x8 pa1, bf16x8 pa2, bf16x8 pa3) {
#define TRRD(dst, off) asm volatile("ds_read_b64_tr_b16 %0, %1 offset:%2" : "=&v"(dst) : "v"(vb0), "i"(off) : "memory")
#define PV_D0(d0) do { s16x4 l0, l1, l2, l3, h0, h1, h2, h3; constexpr int b_ = VB * SHM_V + (d0) * 512;     \
        TRRD(l0, b_); TRRD(h0, b_ + 1024); TRRD(l1, b_ + 2048); TRRD(h1, b_ + 3072); TRRD(l2, b_ + 4096); TRRD(h2, b_ + 5120); TRRD(l3, b_ + 6144); TRRD(h3, b_ + 7168); \
        asm volatile("s_waitcnt lgkmcnt(0)" ::: "memory"); SBAR();   \
        o[d0] = __builtin_amdgcn_mfma_f32_32x32x16_bf16(pa0, (bf16x8){l0[0], l0[1], l0[2], l0[3], h0[0], h0[1], h0[2], h0[3]}, o[d0], 0, 0, 0);   \
        o[d0] = __builtin_amdgcn_mfma_f32_32x32x16_bf16(pa1, (bf16x8){l1[0], l1[1], l1[2], l1[3], h1[0], h1[1], h1[2], h1[3]}, o[d0], 0, 0, 0);   \
        o[d0] = __builtin_amdgcn_mfma_f32_32x32x16_bf16(pa2, (bf16x8){l2[0], l2[1], l2[2], l2[3], h2[0], h2[1], h2[2], h2[3]}, o[d0], 0, 0, 0);   \
        o[d0] = __builtin_amdgcn_mfma_f32_32x32x16_bf16(pa3, (bf16x8){l3[0], l3[1], l3[2], l3[3], h3[0], h3[1], h3[2], h3[3]}, o[d0], 0, 0, 0); } while (0)
    PV_D0(0); PV_D0(1);
#undef PV_D0
#undef TRRD
}

__device__ __forceinline__ void attn_block(const bf16* Qp, const bf16* Kp, const bf16* Vp, bf16* Op, int OLD, int P0, char* lds) {
    int tid_ = threadIdx.x; asm volatile("" : "+v"(tid_));
    const int tid = tid_, wid = __builtin_amdgcn_readfirstlane(tid >> 6), lane = tid & 63, r32 = lane & 31, hi = lane >> 5;
    const int NT = (P0 + QB) / KVBLK;
    const int qlo = P0 + wid * QBLK, qm = qlo + r32 - 4 * hi;
    char* V_lds = lds; char* K_lds = lds + 2 * SHM_V;
    float* wsf = (float*)(lds + 2 * SHM_V + 2 * SHM_K) + wid * 64; float* li_l = wsf, * al_l = wsf + 32;
    float m_reg = -1e30f, l_reg = 0; f32x16 o[2] = {};
    const int sr = tid >> 4, sci = tid & 15; const bool kact = sci < 12;
    const int kws = KSWZ(sr, sci * 16);
    const int vr = tid >> 3, vc = (tid & 7) * 8, vst = v_st(vr, vc);
    const int vb0 = (int)(uintptr_t)V_lds + v_rd_base(lane);
    bf16x8 st_k0, st_k1, st_v;
    st_k0 = bf16x8{}; st_k1 = bf16x8{};
#define SLOAD(k0) do { if (kact) { st_k0 = *(const bf16x8*)(Kp + (size_t)((k0) + sr) * KLD + sci * 8); st_k1 = *(const bf16x8*)(Kp + (size_t)((k0) + 32 + sr) * KLD + sci * 8); } \
                       st_v = *(const bf16x8*)(Vp + (size_t)((k0) + vr) * VLD + vc); } while (0)
#define SWRITE_K(bf) do { if (kact) { *(bf16x8*)(K_lds + (bf) * SHM_K + kws) = st_k0; *(bf16x8*)(K_lds + (bf) * SHM_K + kws + 32 * 256) = st_k1; } } while (0)
#define SWRITE_V(bf) do { *(bf16x8*)(V_lds + (bf) * SHM_V + vst) = st_v; } while (0)
#define VMW() asm volatile("s_waitcnt vmcnt(0)" ::: "memory")
#define RESC(a) do { if (__any((a) < 1.f)) { if (hi == 0) al_l[r32] = (a); asm volatile("s_waitcnt lgkmcnt(0)" ::: "memory");              \
                     _Pragma("unroll") for (int d_ = 0; d_ < 2; ++d_) _Pragma("unroll") for (int r = 0; r < 16; ++r) o[d_][r] *= al_l[crow(r, hi)]; } } while (0)
#define KBASE(t) ((t) * KVBLK)
#define MASKT(P0_, P1_, t) do { const int kb_ = KBASE(t); if (kb_ + KVBLK - 1 > qlo) mask_tile(P0_, P1_, qm - kb_); } while (0)
    bf16x8 qr[6];
#pragma unroll
    for (int d0 = 0; d0 < 6; ++d0) qr[d0] = *(const bf16x8*)(Qp + (size_t)(wid * QBLK + r32) * QLD + d0 * 16 + hi * 8);
    SLOAD(0); VMW(); SWRITE_K(0); SWRITE_V(0); SBAR();
    SLOAD(KBASE(1));
    __syncthreads();
    f32x16 pA0, pA1, pB0, pB1; float alA, alB; bf16x8 pa0, pa1, pa2, pa3;
    SBAR(); qkt<0>(pA0, pA1, K_lds, r32, hi, qr);
    MASKT(pA0, pA1, 0); partialSM(pA0, pA1, m_reg, alA);
    VMW(); SWRITE_K(1); SWRITE_V(1);
    __syncthreads();
#define HALF_STEP(PX0, PX1, alX, PY0, PY1, alY, t, KB, VB, SB) do {                                                      \
        SBAR(); qkt<KB>(PX0, PX1, K_lds, r32, hi, qr);                                                                  \
        finishSM(PY0, PY1, alY, l_reg, pa0, pa1, pa2, pa3); SBAR();                                                     \
        if ((t) + 1 < NT) { SLOAD(KBASE((t) + 1)); SBAR(); }                                                            \
        pv_tile<VB>(o, vb0, pa0, pa1, pa2, pa3); MASKT(PX0, PX1, (t)); partialSM(PX0, PX1, m_reg, alX);                 \
        __syncthreads();                                                                                                \
        if ((t) + 1 < NT) { VMW(); SWRITE_K(SB); SWRITE_V(SB); }                                                        \
        RESC(alX); __syncthreads(); } while (0)
    for (int t = 1; t + 1 < NT; t += 2) {
        HALF_STEP(pB0, pB1, alB, pA0, pA1, alA, t, 1, 0, 0);
        HALF_STEP(pA0, pA1, alA, pB0, pB1, alB, t + 1, 0, 1, 1);
    }
    SBAR(); qkt<1>(pB0, pB1, K_lds, r32, hi, qr); SBAR();
    finishSM(pA0, pA1, alA, l_reg, pa0, pa1, pa2, pa3); SBAR();
    pv_tile<0>(o, vb0, pa0, pa1, pa2, pa3);
    MASKT(pB0, pB1, NT - 1); partialSM(pB0, pB1, m_reg, alB); RESC(alB);
    finishSM(pB0, pB1, alB, l_reg, pa0, pa1, pa2, pa3); SBAR(); pv_tile<1>(o, vb0, pa0, pa1, pa2, pa3);
    if (hi == 0) li_l[r32] = l_reg; asm volatile("s_waitcnt lgkmcnt(0)" ::: "memory");
    float rli[16];
#pragma unroll
    for (int r = 0; r < 16; ++r) rli[r] = __builtin_amdgcn_rcpf(li_l[crow(r, hi)]);
    bf16* Ow = Op + (size_t)(wid * QBLK) * OLD;
#pragma unroll
    for (int r = 0; r < 16; ++r) { const int orow = crow(r, hi);
#pragma unroll
        for (int d0 = 0; d0 < 2; ++d0) { const float v = o[d0][r] * rli[r];
            const float vn = __shfl_xor(v, 1);
            if ((r32 & 1) == 0) *(unsigned*)(Ow + (size_t)orow * OLD + d0 * 32 + r32) = cvtpk(v, vn); } }
    __syncthreads();
#undef SLOAD
#undef SWRITE_K
#undef SWRITE_V
#undef VMW
#undef RESC
#undef KBASE
#undef MASKT
#undef HALF_STEP
}
#undef KSWZ
#undef SBAR
}

__device__ __forceinline__ void p3_attention(Frame& F) {
    const bf16* Q = (const bf16*)(F.ws + WS_Q); const bf16* K = (const bf16*)(F.ws + WS_K); const bf16* V = (const bf16*)(F.ws + WS_V); bf16* O = (bf16*)(F.ws + WS_MIX);
    for (int item = F.vcu; item < NBATCH * NH * 16; item += F.G) {
        const int bh = item >> 4, x = item & 15, b = bh >> 3, h = bh & 7;
        const size_t rowbase = (size_t)b * SEQ;
#pragma unroll 1
        for (int pass = 0; pass < 2; ++pass) {
            const int qb = pass ? 31 - x : x;
            att::attn_block(Q + (rowbase + (size_t)qb * 256) * QLD + h * DQK, K + rowbase * KLD + h * DQK, V + rowbase * VLD + h * DV,
                            O + (rowbase + (size_t)qb * 256) * DM + h * DV, DM, qb * 256, (char*)F.lds);
        }
    }
}

__device__ __forceinline__ float gelu_f(float x) {
    const float t = 1.5957691216057308f * (x + 0.044715f * x * x * x);
    return x * __builtin_amdgcn_rcpf(1.f + __builtin_amdgcn_exp2f(-1.4426950408889634f * t));
}
constexpr int SG_VT_STRIDE = 136;
constexpr int SG_WAVE_BYTES = 64 * SG_VT_STRIDE * 2;
constexpr int SG_XCH_OFF = NWAVES * SG_WAVE_BYTES;
static_assert(SG_XCH_OFF + 2 * 128 * 8 * 4 <= LDSCTL_OFF, "SG LDS");
__device__ __forceinline__ void p4_sg(Frame& F, const Args& A) {
    int lane_ = F.lane; asm volatile("" : "+v"(lane_));
    const int lane = lane_, h = F.wave, r32 = lane & 31, hi = lane >> 5;
    int vz = 0; asm volatile("" : "+v"(vz));
    const bf16* z = (const bf16*)(F.ws + WS_Z); bf16* mix = (bf16*)(F.ws + WS_MIX); float* rstd1 = (float*)(F.ws + WS_RSTD1);
    const float* sg_norm_g = A.in[9]; const float* w_sp = A.in[10]; const float* b_sp = A.in[11]; const float* sg_out_g = A.in[13];
    LAS unsigned char* my = F.lds + h * SG_WAVE_BYTES;
    LAS float* xsg = (LAS float*)(F.lds + SG_XCH_OFF); LAS float* xml = xsg + 128 * 8;
    for (int unit = F.vcu; unit < NBATCH * (SEQ / SGC); unit += F.G) {
        const size_t row0 = (size_t)unit * SGC;
#pragma unroll 1
        for (int half = 0; half < 2; ++half) {
            const int s = lane + 64 * half;
            asm volatile("" : "+v"(vz));
            const bf16* vp = z + (row0 + s) * ZLD + ZC_V + h * SGD;
            float v[64]; float ss = 0.f;
#pragma unroll
            for (int ch = 0; ch < 8; ++ch) { const v4u w = *(const v4u*)(vp + ch * 8);
#pragma unroll
                for (int q = 0; q < 4; ++q) { const float a = gelu_f(bflo(w[q])), b = gelu_f(bfhi(w[q])); v[ch * 8 + 2 * q] = a; v[ch * 8 + 2 * q + 1] = b; ss += a * a + b * b; } }
            const float rs = rsqrtf(ss * (1.f / 64.f) + EPS);
#pragma unroll
            for (int c = 0; c < 64; ++c) *(LAS unsigned short*)(my + (c * SG_VT_STRIDE + s) * 2) = (unsigned short)f2bf(v[c] * rs * sg_norm_g[h * SGD + c + vz]);
        }
        LDS_WAIT(); asm volatile("" ::: "memory");
#pragma unroll 1
        for (int cb = 0; cb < 2; ++cb) {
            f32x16 acc[4];
#pragma unroll
            for (int tb = 0; tb < 4; ++tb) {
                acc[tb] = f32x16{};
                int t = 32 * tb + r32; asm volatile("" : "+v"(t));
                const float* wrow = w_sp + ((size_t)h * SGC + t) * SGC;
#pragma unroll
                for (int ks = 0; ks < 8; ++ks) {
                    if (ks <= 2 * tb + 1) {
                        const int s0 = 16 * ks + 8 * hi;
                        const f32x4 w0 = *(const f32x4*)(wrow + s0), w1 = *(const f32x4*)(wrow + s0 + 4);
                        float wv[8] = {w0[0], w0[1], w0[2], w0[3], w1[0], w1[1], w1[2], w1[3]};
                        if (ks >= 2 * tb) {
#pragma unroll
                            for (int j = 0; j < 8; ++j) wv[j] = (s0 + j > t) ? 0.f : wv[j];
                        }
                        v4u aw; aw.x = pk2(wv[0], wv[1]); aw.y = pk2(wv[2], wv[3]); aw.z = pk2(wv[4], wv[5]); aw.w = pk2(wv[6], wv[7]);
                        const bf16x8 a = __builtin_bit_cast(bf16x8, aw);
                        const bf16x8 b0 = *(const LAS bf16x8*)(my + ((32 * cb + r32) * SG_VT_STRIDE + s0) * 2);
                        acc[tb] = __builtin_amdgcn_mfma_f32_32x32x16_bf16(a, b0, acc[tb], 0, 0, 0);
                    }
                    if (ks & 1) asm volatile("" ::: "memory");
                }
            }
            LDS_WAIT(); asm volatile("" ::: "memory");
#pragma unroll
            for (int tb = 0; tb < 4; ++tb)
#pragma unroll
                for (int r = 0; r < 16; ++r) {
                    const int t = 32 * tb + (r & 3) + 8 * (r >> 2) + 4 * hi;
                    *(LAS unsigned short*)(my + cb * 8704 + t * 64 + (((r32 >> 3) ^ ((t >> 2) & 3)) << 4) + (r32 & 7) * 2) = (unsigned short)f2bf(acc[tb][r]);
                }
            LDS_WAIT(); asm volatile("" ::: "memory");
        }
#pragma unroll 1
        for (int half = 0; half < 2; ++half) {
            const int t = lane + 64 * half;
            const bf16* up = z + (row0 + t) * ZLD + ZC_U + h * SGD;
            const bf16* mp = mix + (row0 + t) * DM + h * DV;
            const float bias = b_sp[h * SGC + t];
            float ss = 0.f, sm = 0.f;
#pragma unroll
            for (int ch = 0; ch < 8; ++ch) {
                LAS v4u* vmp = (LAS v4u*)(my + (ch >> 2) * 8704 + t * 64 + (((ch & 3) ^ ((t >> 2) & 3)) << 4));
                const v4u vw = *vmp; const v4u uw = *(const v4u*)(up + ch * 8); const v4u mw = *(const v4u*)(mp + ch * 8);
                v4u ow;
#pragma unroll
                for (int q = 0; q < 4; ++q) {
                    const float o0 = gelu_f(bflo(uw[q])) * (bflo(vw[q]) + bias), o1 = gelu_f(bfhi(uw[q])) * (bfhi(vw[q]) + bias);
                    ss += o0 * o0 + o1 * o1; ow[q] = pk2(o0, o1);
                    const float m0 = bflo(mw[q]), m1 = bfhi(mw[q]); sm += m0 * m0 + m1 * m1;
                }
                *vmp = ow;
            }
            xsg[t * 8 + h] = ss; xml[t * 8 + h] = sm;
        }
        LDS_WAIT(); __syncthreads();
#pragma unroll 1
        for (int half = 0; half < 2; ++half) {
            const int t = lane + 64 * half;
            asm volatile("" : "+v"(vz));
            float t2 = 0.f, t1 = 0.f;
#pragma unroll
            for (int k = 0; k < 8; ++k) { t2 += xsg[t * 8 + k]; t1 += xml[t * 8 + k]; }
            const float r1 = rsqrtf(t1 * (1.f / 512.f) + EPS);
            const float f = rsqrtf(t2 * (1.f / 512.f) + EPS) / r1;
            if (h == 0) rstd1[row0 + t] = r1;
            bf16* op = mix + (row0 + t) * DM + 512 + h * SGD;
#pragma unroll
            for (int ch = 0; ch < 8; ++ch) {
                const v4u ow = *(LAS v4u*)(my + (ch >> 2) * 8704 + t * 64 + (((ch & 3) ^ ((t >> 2) & 3)) << 4));
                const f32x4 g0 = *(const f32x4*)(sg_out_g + h * SGD + ch * 8 + vz), g1 = *(const f32x4*)(sg_out_g + h * SGD + ch * 8 + 4 + vz);
                v4u w;
                w.x = pk2(bflo(ow.x) * f * g0[0], bfhi(ow.x) * f * g0[1]); w.y = pk2(bflo(ow.y) * f * g0[2], bfhi(ow.y) * f * g0[3]);
                w.z = pk2(bflo(ow.z) * f * g1[0], bfhi(ow.z) * f * g1[1]); w.w = pk2(bflo(ow.w) * f * g1[2], bfhi(ow.w) * f * g1[3]);
                *(v4u*)(op + ch * 8) = w;
            }
        }
        LDS_WAIT(); __syncthreads();
    }
}

namespace pg8 {
struct EpiT {
    static constexpr bool PERM = true, AFTER_DRAIN = false;
    bf16_t* T; const float* rstd1; float* tpart;
    __device__ __forceinline__ void operator()(const f32x4 (&acc)[2][2][4][2], const Unit& u, int wr, int wc, int fr, int fq) const {
        const int row0 = u.pm * BM + wr * 64 + fr, col0 = u.pn * BM + wc * 32 + 8 * fq;
#pragma unroll
        for (int ai = 0; ai < 2; ++ai)
#pragma unroll
            for (int m = 0; m < 4; ++m) {
                const int row = row0 + ai * HALF + m * 16; const float rs = rstd1[row]; float s = 0.f;
#pragma unroll
                for (int bj = 0; bj < 2; ++bj) {
                    const f32x4 v0 = acc[ai][bj][m][0] * rs, v1 = acc[ai][bj][m][1] * rs;
                    u32x4 w; w.x = cvt_pk_bf16(v0[0], v0[1]); w.y = cvt_pk_bf16(v0[2], v0[3]); w.z = cvt_pk_bf16(v1[0], v1[1]); w.w = cvt_pk_bf16(v1[2], v1[3]);
                    *(u32x4*)(T + (size_t)row * 1024 + col0 + bj * HALF) = w;
                    s += (v0[0] * v0[0] + v0[1] * v0[1]) + (v0[2] * v0[2] + v0[3] * v0[3]) + (v1[0] * v1[0] + v1[1] * v1[1]) + (v1[2] * v1[2] + v1[3] * v1[3]);
                }
                s += __shfl_xor(s, 16); s += __shfl_xor(s, 32);
                if (fq == 0) tpart[row * 16 + u.pn * 4 + wc] = s;
            }
    }
};
}

constexpr int P6_LG_OFF = 0;
__device__ __forceinline__ void p6_rowpass(Frame& F, const Args& A) {
    int lane_ = F.lane; asm volatile("" : "+v"(lane_));
    const int lane = lane_, r = lane & 15, kg = lane >> 4;
    const bf16* tb = (const bf16*)(F.ws + WS_TB); const float* tpart = (const float*)(F.ws + WS_TPART);
    const float* x = A.in[0]; const float* gpost = A.in[15]; const bf16* wr = (const bf16*)(F.ws + WS_WR); const float* brt = A.in[18];
    float* x1 = F.out; bf16* x1b = (bf16*)(F.ws + WS_X1B); float* rstdx1 = (float*)(F.ws + WS_RSTDX1);
    int* topi = (int*)(F.ws + WS_TOPI); float* topw = (float*)(F.ws + WS_TOPW);
    LAS float* lg = (LAS float*)(F.lds + P6_LG_OFF) + F.wave * (16 * 33);
    LAS int* hist = (LAS int*)(F.lds + 17408);
    int* rbhist = (int*)(F.ws + WS_RBHIST);
    for (int rb = F.vcu; rb < M / 64; rb += F.G) {
      if (F.tid < 32) hist[F.tid] = 0;
      LDS_WAIT(); __syncthreads();
      if (F.wave < 4) {
        const int blk = rb * 4 + F.wave;
        const size_t row = (size_t)blk * 16 + r;
        float ts = 0.f;
        { const f32x4* tp = (const f32x4*)(tpart + row * 16);
#pragma unroll
          for (int q = 0; q < 4; ++q) { const f32x4 v = tp[q]; ts += (v[0] + v[1]) + (v[2] + v[3]); } }
        const float rst = rsqrtf(ts * (1.f / 1024.f) + EPS);
        f32x4 acc0 = {0.f, 0.f, 0.f, 0.f}, acc1 = {0.f, 0.f, 0.f, 0.f};
        float ss = 0.f;
#pragma unroll 4
        for (int s = 0; s < 32; ++s) {
            const int k = 32 * s + 8 * kg;
            const v4u tw = *(const v4u*)(tb + row * DM + k);
            const f32x4 xa = *(const f32x4*)(x + row * DM + k), xb_ = *(const f32x4*)(x + row * DM + k + 4);
            const f32x4 ga = *(const f32x4*)(gpost + k), gb = *(const f32x4*)(gpost + k + 4);
            f32x4 ya, yb;
            ya[0] = xa[0] + bflo(tw.x) * rst * ga[0]; ya[1] = xa[1] + bfhi(tw.x) * rst * ga[1]; ya[2] = xa[2] + bflo(tw.y) * rst * ga[2]; ya[3] = xa[3] + bfhi(tw.y) * rst * ga[3];
            yb[0] = xb_[0] + bflo(tw.z) * rst * gb[0]; yb[1] = xb_[1] + bfhi(tw.z) * rst * gb[1]; yb[2] = xb_[2] + bflo(tw.w) * rst * gb[2]; yb[3] = xb_[3] + bfhi(tw.w) * rst * gb[3];
            *(f32x4*)(x1 + row * DM + k) = ya; *(f32x4*)(x1 + row * DM + k + 4) = yb;
            v4u aw; aw.x = pk2(ya[0], ya[1]); aw.y = pk2(ya[2], ya[3]); aw.z = pk2(yb[0], yb[1]); aw.w = pk2(yb[2], yb[3]);
            *(v4u*)(x1b + row * DM + k) = aw;
            { const float q0 = bflo(aw.x), q1 = bfhi(aw.x), q2 = bflo(aw.y), q3 = bfhi(aw.y), q4 = bflo(aw.z), q5 = bfhi(aw.z), q6 = bflo(aw.w), q7 = bfhi(aw.w);
              ss += (q0 * q0 + q1 * q1) + (q2 * q2 + q3 * q3) + (q4 * q4 + q5 * q5) + (q6 * q6 + q7 * q7); }
            const bf16x8 a = __builtin_bit_cast(bf16x8, aw);
            const bf16x8 b0 = *(const bf16x8*)(wr + (size_t)r * DM + k), b1 = *(const bf16x8*)(wr + (size_t)(16 + r) * DM + k);
            acc0 = __builtin_amdgcn_mfma_f32_16x16x32_bf16(a, b0, acc0, 0, 0, 0);
            acc1 = __builtin_amdgcn_mfma_f32_16x16x32_bf16(a, b1, acc1, 0, 0, 0);
        }
        ss += __shfl_xor(ss, 16); ss += __shfl_xor(ss, 32);
        const float rs1 = rsqrtf(ss * (1.f / 1024.f) + EPS);
        if (kg == 0) rstdx1[row] = rs1;
#pragma unroll
        for (int i = 0; i < 4; ++i) { lg[(4 * kg + i) * 33 + r] = acc0[i]; lg[(4 * kg + i) * 33 + 16 + r] = acc1[i]; }
        LDS_WAIT(); asm volatile("" ::: "memory");
        if (kg == 0) {
            float v[32];
#pragma unroll
            for (int e = 0; e < 32; ++e) v[e] = lg[r * 33 + e] * rs1 + brt[e];
            int idx[4]; float val[4];
#pragma unroll
            for (int k = 0; k < 4; ++k) {
                int bi = 0; float bv = -3.0e38f;
#pragma unroll
                for (int e = 0; e < 32; ++e) if (v[e] > bv) { bv = v[e]; bi = e; }
                idx[k] = bi; val[k] = bv;
#pragma unroll
                for (int e = 0; e < 32; ++e) if (e == bi) v[e] = -3.0e38f;
            }
            float ex[4], sum = 0.f;
#pragma unroll
            for (int k = 0; k < 4; ++k) { ex[k] = __expf(val[k] - val[0]); sum += ex[k]; }
            const float inv = 1.f / sum;
            *(int4*)(topi + row * 4) = make_int4(idx[0], idx[1], idx[2], idx[3]);
            *(f32x4*)(topw + row * 4) = (f32x4){ex[0] * inv, ex[1] * inv, ex[2] * inv, ex[3] * inv};
#pragma unroll
            for (int k = 0; k < 4; ++k) (void)__hip_atomic_fetch_add(hist + idx[k], 1, __ATOMIC_RELAXED, __HIP_MEMORY_SCOPE_WORKGROUP);
        }
      }
      LDS_WAIT(); __syncthreads();
      if (F.tid < 32) rbhist[rb * 32 + F.tid] = hist[F.tid];
    }
}

constexpr int NRB = M / 64;
constexpr int P7_LDS_E = 0, P7_LDS_BASE = 1024, P7_LDS_RED = 2048, P7_LDS_DEST = 8192;
__device__ __forceinline__ void p7_route(Frame& F) {
    int tid_ = F.tid; asm volatile("" : "+v"(tid_));
    const int tid = tid_;
    unsigned char* ws = F.ws;
    const int* topi = (const int*)(ws + WS_TOPI); const float* topw = (const float*)(ws + WS_TOPW); const float* rstdx1 = (const float*)(ws + WS_RSTDX1);
    const int* rbhist = (const int*)(ws + WS_RBHIST); int* rowslot = (int*)(ws + WS_ROWSLOT); float* roww = (float*)(ws + WS_ROWW); float* rss = (float*)(ws + WS_RSS);
    int* texp = (int*)(ws + WS_TEXP);
    const bf16* x1b = (const bf16*)(ws + WS_X1B); bf16* Xs = (bf16*)(ws + WS_XS);
    LAS int* eid = (LAS int*)(F.lds + P7_LDS_E); LAS int* base = (LAS int*)(F.lds + P7_LDS_BASE); LAS int* tot = base + 32; LAS int* off = base + 64;
    LAS int* red = (LAS int*)(F.lds + P7_LDS_RED); LAS int* dst = (LAS int*)(F.lds + P7_LDS_DEST);
    for (int rb = F.vcu; rb < NRB; rb += F.G) {
        { const int e = tid & 31, part = tid >> 5; int sb = 0, st = 0;
#pragma unroll 4
          for (int i = 0; i < 16; ++i) { const int r2 = part * 16 + i; const int c = rbhist[r2 * 32 + e]; st += c; if (r2 < rb) sb += c; }
          red[part * 32 + e] = sb; red[512 + part * 32 + e] = st; }
        if (tid < 256) eid[tid] = topi[(size_t)rb * 256 + tid];
        LDS_WAIT(); __syncthreads();
        if (tid < 32) { int sb = 0, st = 0;
#pragma unroll
            for (int p = 0; p < 16; ++p) { sb += red[p * 32 + tid]; st += red[512 + p * 32 + tid]; }
            base[tid] = sb; tot[tid] = st; }
        LDS_WAIT(); __syncthreads();
        if (tid == 0) { int o = 0;
            for (int e = 0; e < 32; ++e) { off[e] = o; o += (tot[e] + 255) & ~255; }
            if (rb == 0) { F.ctl[CW_NTILES] = (unsigned)(o >> 8);
                for (int e = 0; e < 32; ++e) { const int t0 = off[e] >> 8, nt = (tot[e] + 255) >> 8; for (int t = 0; t < nt; ++t) texp[t0 + t] = e; } } }
        LDS_WAIT(); __syncthreads();
        if (tid < 256) {
            const int e = eid[tid]; int rank = 0;
            for (int j = 0; j < tid; ++j) rank += (eid[j] == e) ? 1 : 0;
            const int d = off[e] + base[e] + rank; dst[tid] = d;
            const int row = rb * 64 + (tid >> 2);
            rowslot[d] = row * 4 + (tid & 3); roww[d] = topw[(size_t)rb * 256 + tid]; rss[d] = rstdx1[row];
        }
        if (rb < 32) {
            const int e = rb, c = tot[e], pe = (c + 255) & ~255;
            if (tid < pe - c) { rowslot[off[e] + c + tid] = -1; roww[off[e] + c + tid] = 0.f; rss[off[e] + c + tid] = 0.f; }
        }
        LDS_WAIT(); __syncthreads();
        for (int i = tid; i < 256 * 128; i += NWAVES * 64) {
            const int ent = i >> 7, ch = i & 127; const int row = rb * 64 + (ent >> 2);
            const v4u v = *(const v4u*)(x1b + (size_t)row * DM + ch * 8);
            *(v4u*)(Xs + (size_t)dst[ent] * DM + ch * 8) = v;
        }
        LDS_WAIT(); __syncthreads();
    }
}

namespace pg8 {
struct MoeOrder {
    StaticOrder so; const int* texp; int nn;
    __device__ void init(int ntiles, int nn_, int G_, int c_, const int* texp_) { so.init(ntiles * BM, nn_ * BM, G_, c_); texp = texp_; nn = nn_; }
    __device__ bool next(int i, Unit& u) const { if (!so.next(i, u)) return false; const int e = texp[u.pm]; u.pn += e * nn; return true; }
    __device__ __forceinline__ void a_ready(const Unit&) const {}
    __device__ __forceinline__ void done(const Unit&) const {}
};
struct EpiGU {
    static constexpr bool PERM = false, AFTER_DRAIN = false;
    bf16_t* Hs; const float* rss; const float* bgu;
    __device__ __forceinline__ void operator()(const f32x4 (&acc)[2][2][4][2], const Unit& u, int wr, int wc, int fr, int fq) const {
        const int e = u.pn >> 3, pnl = u.pn & 7;
        const int row0 = u.pm * BM + wr * 64 + fr;
        f32x4 bg[2], bu[2];
#pragma unroll
        for (int bj = 0; bj < 2; ++bj) { const int jb = 128 * pnl + 64 * bj + 16 * wc + 4 * fq; bg[bj] = *(const f32x4*)(bgu + e * 2048 + jb); bu[bj] = *(const f32x4*)(bgu + e * 2048 + 1024 + jb); }
#pragma unroll
        for (int ai = 0; ai < 2; ++ai)
#pragma unroll
            for (int m = 0; m < 4; ++m) {
                const int row = row0 + ai * HALF + m * 16; const float rs = rss[row];
#pragma unroll
                for (int bj = 0; bj < 2; ++bj) {
                    const int jb = 128 * pnl + 64 * bj + 16 * wc + 4 * fq;
                    float a[4];
#pragma unroll
                    for (int i = 0; i < 4; ++i) {
                        float g = acc[ai][bj][m][0][i] * rs + bg[bj][i], uu = acc[ai][bj][m][1][i] * rs + bu[bj][i];
                        g = fminf(g, 7.f); uu = fminf(fmaxf(uu, -7.f), 7.f);
                        a[i] = (uu + 1.f) * g * __builtin_amdgcn_rcpf(1.f + __builtin_amdgcn_exp2f(-1.702f * 1.4426950408889634f * g));
                    }
                    v2u w; w.x = cvt_pk_bf16(a[0], a[1]); w.y = cvt_pk_bf16(a[2], a[3]);
                    *(v2u*)(Hs + (size_t)row * 1024 + jb) = w;
                }
            }
    }
};
struct EpiDown {
    static constexpr bool PERM = true, AFTER_DRAIN = false;
    bf16_t* Y; const int* rowslot; const float* roww; const float* bd;
    __device__ __forceinline__ void operator()(const f32x4 (&acc)[2][2][4][2], const Unit& u, int wr, int wc, int fr, int fq) const {
        const int e = u.pn >> 2, pnl = u.pn & 3;
        const int row0 = u.pm * BM + wr * 64 + fr, col0 = pnl * BM + wc * 32 + 8 * fq;
        f32x4 b0[2], b1[2];
#pragma unroll
        for (int bj = 0; bj < 2; ++bj) { b0[bj] = *(const f32x4*)(bd + e * 1024 + col0 + bj * HALF); b1[bj] = *(const f32x4*)(bd + e * 1024 + col0 + bj * HALF + 4); }
#pragma unroll
        for (int ai = 0; ai < 2; ++ai)
#pragma unroll
            for (int m = 0; m < 4; ++m) {
                const int row = row0 + ai * HALF + m * 16; const int slot = rowslot[row]; const float gw = roww[row];
                if (slot >= 0) {
#pragma unroll
                    for (int bj = 0; bj < 2; ++bj) {
                        const f32x4 v0 = (acc[ai][bj][m][0] + b0[bj]) * gw, v1 = (acc[ai][bj][m][1] + b1[bj]) * gw;
                        u32x4 w; w.x = cvt_pk_bf16(v0[0], v0[1]); w.y = cvt_pk_bf16(v0[2], v0[3]); w.z = cvt_pk_bf16(v1[0], v1[1]); w.w = cvt_pk_bf16(v1[2], v1[3]);
                        *(u32x4*)(Y + (size_t)slot * 1024 + col0 + bj * HALF) = w;
                    }
                }
            }
    }
};
struct EpiPle {
    static constexpr bool PERM = true, AFTER_DRAIN = false;
    bf16_t* V; const bf16_t* PP; const float* bias; float* vpart;
    __device__ __forceinline__ void operator()(const f32x4 (&acc)[2][2][4][2], const Unit& u, int wr, int wc, int fr, int fq) const {
        const int row0 = u.pm * BM + wr * 64 + fr, col0 = u.pn * BM + wc * 32 + 8 * fq;
        f32x4 b0[2], b1[2];
#pragma unroll
        for (int bj = 0; bj < 2; ++bj) { b0[bj] = *(const f32x4*)(bias + col0 + bj * HALF); b1[bj] = *(const f32x4*)(bias + col0 + bj * HALF + 4); }
#pragma unroll
        for (int ai = 0; ai < 2; ++ai)
#pragma unroll
            for (int m = 0; m < 4; ++m) {
                const int row = row0 + ai * HALF + m * 16; float s = 0.f;
#pragma unroll
                for (int bj = 0; bj < 2; ++bj) {
                    const u32x4 pw = *(const u32x4*)(PP + (size_t)row * 1024 + col0 + bj * HALF);
                    const f32x4 l0 = acc[ai][bj][m][0] + b0[bj], l1 = acc[ai][bj][m][1] + b1[bj];
                    float v[8];
#pragma unroll
                    for (int i = 0; i < 4; ++i) {
                        v[i] = __builtin_amdgcn_rcpf(1.f + __builtin_amdgcn_exp2f(-1.4426950408889634f * l0[i]));
                        v[4 + i] = __builtin_amdgcn_rcpf(1.f + __builtin_amdgcn_exp2f(-1.4426950408889634f * l1[i]));
                    }
                    v[0] *= __builtin_bit_cast(float, pw.x << 16); v[1] *= __builtin_bit_cast(float, pw.x & 0xffff0000u);
                    v[2] *= __builtin_bit_cast(float, pw.y << 16); v[3] *= __builtin_bit_cast(float, pw.y & 0xffff0000u);
                    v[4] *= __builtin_bit_cast(float, pw.z << 16); v[5] *= __builtin_bit_cast(float, pw.z & 0xffff0000u);
                    v[6] *= __builtin_bit_cast(float, pw.w << 16); v[7] *= __builtin_bit_cast(float, pw.w & 0xffff0000u);
                    u32x4 w; w.x = cvt_pk_bf16(v[0], v[1]); w.y = cvt_pk_bf16(v[2], v[3]); w.z = cvt_pk_bf16(v[4], v[5]); w.w = cvt_pk_bf16(v[6], v[7]);
                    *(u32x4*)(V + (size_t)row * 1024 + col0 + bj * HALF) = w;
                    s += (v[0] * v[0] + v[1] * v[1]) + (v[2] * v[2] + v[3] * v[3]) + (v[4] * v[4] + v[5] * v[5]) + (v[6] * v[6] + v[7] * v[7]);
                }
                s += __shfl_xor(s, 16); s += __shfl_xor(s, 32);
                if (fq == 0) vpart[row * 16 + u.pn * 4 + wc] = s;
                asm volatile("" ::: "memory");
            }
    }
};
}

__device__ __forceinline__ void p10_rowpass(Frame& F, const Args& A) {
    int lane_ = F.lane; asm volatile("" : "+v"(lane_));
    const int lane = lane_;
    const bf16* ys = (const bf16*)(F.ws + WS_YS); bf16* x2b = (bf16*)(F.ws + WS_X2B); float* xo = F.out; const float* g = A.in[23];
    const int gw = F.vcu * NWAVES + F.wave, NGW = F.G * NWAVES;
    for (int row = gw; row < M; row += NGW) {
        f32x4 y[4]; float ss = 0.f;
#pragma unroll
        for (int j = 0; j < 4; ++j) {
            y[j] = (f32x4){0.f, 0.f, 0.f, 0.f};
#pragma unroll
            for (int k = 0; k < 4; ++k) { const v2u w = *((const v2u*)(ys + ((size_t)row * 4 + k) * DM) + lane + 64 * j);
                y[j][0] += bflo(w.x); y[j][1] += bfhi(w.x); y[j][2] += bflo(w.y); y[j][3] += bfhi(w.y); }
            ss += (y[j][0] * y[j][0] + y[j][1] * y[j][1]) + (y[j][2] * y[j][2] + y[j][3] * y[j][3]);
        }
        const float rs = rsqrtf(wave_sum(ss) * (1.f / DM) + EPS);
#pragma unroll
        for (int j = 0; j < 4; ++j) {
            f32x4* xp = (f32x4*)(xo + (size_t)row * DM) + lane + 64 * j;
            const f32x4 gg = *((const f32x4*)g + lane + 64 * j);
            const f32x4 x2 = *xp + y[j] * rs * gg;
            *xp = x2;
            v2u w; w.x = pk2(x2[0], x2[1]); w.y = pk2(x2[2], x2[3]);
            *((v2u*)(x2b + (size_t)row * DM) + lane + 64 * j) = w;
        }
    }
}
__device__ __forceinline__ void p12_final(Frame& F, const Args& A) {
    int lane_ = F.lane; asm volatile("" : "+v"(lane_));
    const int lane = lane_;
    const bf16* vb = (const bf16*)(F.ws + WS_VB); const float* vpart = (const float*)(F.ws + WS_VPART); float* xo = F.out; const float* g = A.in[27];
    const int gw = F.vcu * NWAVES + F.wave, NGW = F.G * NWAVES;
    for (int row = gw; row < M; row += NGW) {
        float s = (lane < 16) ? vpart[(size_t)row * 16 + lane] : 0.f;
        s = wave_sum(s);
        const float rs = rsqrtf(s * (1.f / DM) + EPS);
#pragma unroll
        for (int j = 0; j < 4; ++j) {
            f32x4* xp = (f32x4*)(xo + (size_t)row * DM) + lane + 64 * j;
            const f32x4 gg = *((const f32x4*)g + lane + 64 * j);
            const v2u w = *((const v2u*)(vb + (size_t)row * DM) + lane + 64 * j);
            f32x4 o = *xp;
            o[0] += bflo(w.x) * rs * gg[0]; o[1] += bfhi(w.x) * rs * gg[1]; o[2] += bflo(w.y) * rs * gg[2]; o[3] += bfhi(w.y) * rs * gg[3];
            *xp = o;
        }
    }
}

constexpr int NPHASE = 13;
template <unsigned PM> __global__ void __launch_bounds__(NWAVES * 64, 2) mk_fwd(Args args) {
    extern __shared__ __attribute__((aligned(16))) unsigned char lds[];
    Frame F;
    F.lds = (LAS unsigned char*)lds;
    F.MISC = (volatile LAS unsigned*)(F.lds + MISC_OFF);
    F.tid = threadIdx.x; F.lane = F.tid & 63; F.wave = __builtin_amdgcn_readfirstlane(F.tid >> 6);
    F.G = gridDim.x; { const int bx = blockIdx.x; F.vcu = (F.G % 8 == 0) ? (bx % 8) * (F.G / 8) + bx / 8 : bx; }
    F.ws = args.ws; F.ctl = (gu32*)(args.ws + WS_CTL); F.out = args.out;
    unsigned char* ws = args.ws;
    for (int u = F.tid; u < (LDS_BYTES - LDSCTL_OFF) / 4; u += NWAVES * 64) ((LAS unsigned*)(F.lds + LDSCTL_OFF))[u] = 0u;
    __syncthreads();
    const bool single = (args.ph_hi - args.ph_lo) > 1;
    XcdBarrier bar; bar.bar = (unsigned*)(F.ctl + CW_BAR); bar.x = 0; bar.st = nullptr;
    if (single) bar = xcd_barrier_post((unsigned*)(F.ctl + CW_BAR), F.MISC + 8);
    const int lo = args.ph_lo, hi = args.ph_hi;
#define IN(k) (((PM >> (k)) & 1) && lo <= (k) && (k) < hi)
#define SEAM(k) do { if (IN(k) && IN((k) + 1)) xcd_barrier(bar); } while (0)

    if (IN(0)) { p0_prologue<MOE_WEIGHTS>(F, args); } SEAM(0);

    if (IN(1)) {
        pg8::Gemm g{(const bf16*)(ws + WS_XB), (const bf16*)(ws + WS_WIN), M, ZLD, DM, DM, DM}; pg8::StaticOrder S; S.init(M, ZLD, F.G, (int)blockIdx.x);
        pg8::EpiZ E{(bf16*)(ws + WS_Z), (const float*)(ws + WS_RSTDX), (float*)(ws + WS_QPART), (float*)(ws + WS_KVPART)};
        pg8::gemm_phase<pg8::EpiZ, pg8::StaticOrder, true, true>(F.lds + RING_OFF, g, S, E);
    } SEAM(1);

    if (IN(2)) {
#ifndef P2SEL
#define P2SEL 15
#endif
        if (P2SEL & 1) p2_krope(F);
        if (P2SEL & 2) { pg8::Gemm g{(const bf16*)(ws + WS_Z), (const bf16*)(ws + WS_WUQ), M, QLD, Q_LORA, ZLD, Q_LORA}; pg8::StaticOrder S; S.init(M, QLD, F.G, (int)blockIdx.x);
          pg8::EpiQ E{(bf16*)(ws + WS_Q), (const float*)(ws + WS_QPART), (const f32x2*)(ws + WS_ROPE)};
          pg8::gemm_phase<pg8::EpiQ, pg8::StaticOrder, true, true>(F.lds + RING_OFF, g, S, E); }
        if (P2SEL & 4) { pg8::Gemm g{(const bf16*)(ws + WS_Z) + ZC_KV, (const bf16*)(ws + WS_WUKV), M, 1024, KV_LORA, ZLD, KV_LORA}; pg8::StaticOrder S; S.init(M, 1024, F.G, (int)blockIdx.x);
          pg8::EpiKV E{(bf16*)(ws + WS_K), (bf16*)(ws + WS_V), (const float*)(ws + WS_KVPART)};
          pg8::gemm_phase<pg8::EpiKV, pg8::StaticOrder, true, true>(F.lds + RING_OFF, g, S, E); }
        if (P2SEL & 8) { pg8::Gemm g{(const bf16*)(ws + WS_PB), (const bf16*)(ws + WS_WPP), M, DM, DPLE, DPLE, DPLE}; pg8::StaticOrder S; S.init(M, DM, F.G, (int)blockIdx.x);
          pg8::EpiStore E{(bf16*)(ws + WS_PPB), DM, nullptr};
          pg8::gemm_phase<pg8::EpiStore, pg8::StaticOrder, true, true>(F.lds + RING_OFF, g, S, E); }
    } SEAM(2);

    if (IN(3)) { p3_attention(F); } SEAM(3);

    if (IN(4)) { p4_sg(F, args); } SEAM(4);

    if (IN(5)) {
        pg8::Gemm g{(const bf16*)(ws + WS_MIX), (const bf16*)(ws + WS_WOUT), M, DM, DM, DM, DM}; pg8::StaticOrder S; S.init(M, DM, F.G, (int)blockIdx.x);
        pg8::EpiT E{(bf16*)(ws + WS_TB), (const float*)(ws + WS_RSTD1), (float*)(ws + WS_TPART)};
        pg8::gemm_phase<pg8::EpiT, pg8::StaticOrder, true, true>(F.lds + RING_OFF, g, S, E);
    } SEAM(5);

    if (IN(6)) { p6_rowpass(F, args); } SEAM(6);

    if (IN(7)) { p7_route(F); } SEAM(7);

    if (IN(8)) {
        const int ntiles = (int)F.ctl[CW_NTILES];
        pg8::Gemm g{(const bf16*)(ws + WS_XS), (const bf16*)(ws + WS_WGU), 0, 0, DM, DM, DM}; pg8::MoeOrder S; S.init(ntiles, 8, F.G, (int)blockIdx.x, (const int*)(ws + WS_TEXP));
        pg8::EpiGU E{(bf16*)(ws + WS_HS), (const float*)(ws + WS_RSS), args.in[20]};
        pg8::gemm_phase<pg8::EpiGU, pg8::MoeOrder, true, true>(F.lds + RING_OFF, g, S, E);
    } SEAM(8);

    if (IN(9)) {
        const int ntiles = (int)F.ctl[CW_NTILES];
        pg8::Gemm g{(const bf16*)(ws + WS_HS), (const bf16*)(ws + WS_WD), 0, 0, DE, DE, DE}; pg8::MoeOrder S; S.init(ntiles, 4, F.G, (int)blockIdx.x, (const int*)(ws + WS_TEXP));
        pg8::EpiDown E{(bf16*)(ws + WS_YS), (const int*)(ws + WS_ROWSLOT), (const float*)(ws + WS_ROWW), args.in[22]};
        pg8::gemm_phase<pg8::EpiDown, pg8::MoeOrder, true, true>(F.lds + RING_OFF, g, S, E);
    } SEAM(9);

    if (IN(10)) { p10_rowpass(F, args); } SEAM(10);

    if (IN(11)) {
        pg8::Gemm g{(const bf16*)(ws + WS_X2B), (const bf16*)(ws + WS_WPG), M, DM, DM, DM, DM}; pg8::StaticOrder S; S.init(M, DM, F.G, (int)blockIdx.x);
        pg8::EpiPle E{(bf16*)(ws + WS_VB), (const bf16*)(ws + WS_PPB), args.in[25], (float*)(ws + WS_VPART)};
        pg8::gemm_phase<pg8::EpiPle, pg8::StaticOrder, true, true>(F.lds + RING_OFF, g, S, E);
    } SEAM(11);

    if (IN(12)) { p12_final(F, args); }
#undef IN
#undef SEAM
}

extern "C" void kernel_launch(void* const* d_in, const int* in_sizes, int n_in, void* d_out, int out_size, void* d_ws, size_t ws_size,
                              hipStream_t stream) {
    static int grid = 0;
    if (grid == 0) {
        int dev = 0, cus = 0;
        if (hipGetDevice(&dev) != hipSuccess || hipDeviceGetAttribute(&cus, hipDeviceAttributeMultiprocessorCount, dev) != hipSuccess) { grid = -1; return; }
        bool ok = true;
#if SINGLE_LAUNCH
        ok = (hipFuncSetAttribute((const void*)mk_fwd<0x1FFFu>, hipFuncAttributeMaxDynamicSharedMemorySize, LDS_BYTES) == hipSuccess);
#else
#define SETA(k) ok = ok && (hipFuncSetAttribute((const void*)mk_fwd<(1u << k)>, hipFuncAttributeMaxDynamicSharedMemorySize, LDS_BYTES) == hipSuccess)
        SETA(0); SETA(1); SETA(2); SETA(3); SETA(4); SETA(5); SETA(6); SETA(7); SETA(8); SETA(9); SETA(10); SETA(11); SETA(12);
#undef SETA
#endif
        if (!ok) { grid = -1; return; }
        grid = cus;
    }
    if (grid < 0 || n_in != 28 || ws_size < WS_END) return;
    float* out = (float*)d_out;
    char* ws = (char*)d_ws;

    (void)hipMemsetAsync(ws + WS_CTL, 0, CTL_ZERO_BYTES, stream);
    Args a{};
    for (int i = 0; i < 28; ++i) a.in[i] = (const float*)d_in[i];
    a.out = out; a.ws = (unsigned char*)d_ws;
#if SINGLE_LAUNCH
    a.ph_lo = 0; a.ph_hi = NPHASE; hipLaunchKernelGGL(mk_fwd<0x1FFFu>, dim3(grid), dim3(NWAVES * 64), LDS_BYTES, stream, a);
#else
#define LAUNCH(k) do { a.ph_lo = k; a.ph_hi = k + 1; hipLaunchKernelGGL(mk_fwd<(1u << k)>, dim3(grid), dim3(NWAVES * 64), LDS_BYTES, stream, a); } while (0)
    LAUNCH(0); LAUNCH(1); LAUNCH(2); LAUNCH(3); LAUNCH(4); LAUNCH(5); LAUNCH(6); LAUNCH(7); LAUNCH(8); LAUNCH(9); LAUNCH(10); LAUNCH(11); LAUNCH(12);
#undef LAUNCH
#endif

}
```

```cpp
#include <hip/hip_runtime.h>
#include <cstdint>
#include <cstdio>

constexpr int DM = 1024, NBATCH = 2, SEQ = 8192, M = NBATCH * SEQ;
constexpr int NH = 8, QK_NOPE = 64, QK_ROPE = 32, DQK = 96, DV = 64, Q_LORA = 256, KV_LORA = 128;
constexpr int SGH = 8, SGD = 64, SGC = 128;
constexpr int NE = 32, TOPK = 4, DE = 1024;
constexpr int DPLE = 256;
constexpr int IN_COLS = 1440;
constexpr float EPS = 1e-6f;

__device__ __forceinline__ float wave_sum(float v) {
#pragma unroll
    for (int o = 1; o < 64; o <<= 1) v += __shfl_xor(v, o);
    return v;
}

#define GAS __attribute__((address_space(1)))
#define LAS __attribute__((address_space(3)))
typedef unsigned short bf16;
typedef unsigned v4u __attribute__((ext_vector_type(4)));
typedef unsigned v2u __attribute__((ext_vector_type(2)));
typedef float f32x4 __attribute__((ext_vector_type(4)));
typedef float f32x2 __attribute__((ext_vector_type(2)));
typedef float f32x16 __attribute__((ext_vector_type(16)));
typedef short bf16x8 __attribute__((ext_vector_type(8)));
typedef short s16x4 __attribute__((ext_vector_type(4)));
typedef GAS unsigned gu32;
#define RLX_AGENT __ATOMIC_RELAXED, __HIP_MEMORY_SCOPE_AGENT
#define LDS_WAIT() asm volatile("s_waitcnt lgkmcnt(0)" ::: "memory")
#define VM_WAIT() asm volatile("s_waitcnt vmcnt(0)" ::: "memory")
__device__ __forceinline__ unsigned f2bf(float f) { unsigned u = __builtin_bit_cast(unsigned, f); return (u + 0x7fffu + ((u >> 16) & 1u)) >> 16; }
__device__ __forceinline__ unsigned pk2(float lo, float hi) { return f2bf(lo) | (f2bf(hi) << 16); }
__device__ __forceinline__ float bf2f(unsigned short b) { return __builtin_bit_cast(float, (unsigned)b << 16); }
__device__ __forceinline__ float bflo(unsigned w) { return __builtin_bit_cast(float, w << 16); }
__device__ __forceinline__ float bfhi(unsigned w) { return __builtin_bit_cast(float, w & 0xffff0000u); }

__device__ __forceinline__ unsigned pk4_fp8(float a, float b, float c, float d) {
    int r = 0; r = __builtin_amdgcn_cvt_pk_fp8_f32(a, b, r, false); r = __builtin_amdgcn_cvt_pk_fp8_f32(c, d, r, true); return (unsigned)r;
}
constexpr float W8_SCALE = 32.f;
constexpr int W8_E8M0 = 0x7A7A7A7A, ONE_E8M0 = 0x7F7F7F7F;
constexpr int NWAVES = 8;
constexpr int ZLD = 1536;
constexpr int ZC_KV = 256, ZC_KR = 384, ZC_U = 512, ZC_V = 1024;
constexpr int QLD = NH * DQK, KLD = NH * DQK, VLD = NH * DV;
constexpr float C2Q = 0.10206207261596575f * 1.4426950408889634f;

constexpr size_t MiB = 1u << 20;
constexpr size_t WS_CTL = 0, CTL_ZERO_BYTES = 1 * MiB;
constexpr size_t WS_RSTDX = 1 * MiB;
constexpr size_t WS_RSTD1 = WS_RSTDX + 64 * 1024;
constexpr size_t WS_RSTDX1 = WS_RSTD1 + 64 * 1024;
constexpr size_t WS_QPART = 2 * MiB;
constexpr size_t WS_KVPART = WS_QPART + 256 * 1024;
constexpr size_t WS_SSMLA = WS_KVPART + 256 * 1024;
constexpr size_t WS_TPART = 3 * MiB;
constexpr size_t WS_VPART = 4 * MiB;
constexpr size_t WS_ROPE = 5 * MiB;
constexpr size_t WS_TOPI = 7 * MiB;
constexpr size_t WS_TOPW = WS_TOPI + 256 * 1024;
constexpr size_t WS_WIN = 8 * MiB;
constexpr size_t WS_WUQ = 11 * MiB;
constexpr size_t WS_WUKV = WS_WUQ + 384 * 1024;
constexpr size_t WS_WR = WS_WUKV + 256 * 1024;
constexpr size_t WS_WOUT = 12 * MiB;
constexpr size_t WS_WPG = 14 * MiB;
constexpr size_t WS_WPP = 16 * MiB;
constexpr size_t WS_WGU = 17 * MiB;
constexpr size_t WS_WD = 145 * MiB;
constexpr size_t WS_XB = 209 * MiB;
constexpr size_t WS_PB = 241 * MiB;
constexpr size_t WS_Z = 249 * MiB;
constexpr size_t WS_Q = 297 * MiB;
constexpr size_t WS_K = 321 * MiB;
constexpr size_t WS_V = 345 * MiB;
constexpr size_t WS_MIX = 361 * MiB;
constexpr size_t WS_PPB = 393 * MiB;
constexpr size_t WS_TB = 425 * MiB;
constexpr size_t WS_X1Q = 457 * MiB;
constexpr size_t WS_XS = 489 * MiB;
constexpr size_t WS_HS = 633 * MiB;
constexpr size_t WS_YS = 777 * MiB;
constexpr size_t WS_X2B = 905 * MiB;
constexpr size_t WS_VB = 937 * MiB;
constexpr size_t WS_END = 969 * MiB;
constexpr size_t WS_RBHIST = 7 * MiB + 512 * 1024;
constexpr size_t WS_TEXP = 7 * MiB + 576 * 1024;
constexpr size_t WS_ROWSLOT = 7 * MiB + 640 * 1024;
constexpr size_t WS_ROWW = 1 * MiB + 256 * 1024;
constexpr size_t WS_RSS = 1 * MiB + 576 * 1024;
constexpr int CW_NTILES = 64;

constexpr int RING_OFF = 0, RING_BYTES = 131072;
constexpr int SCR_BYTES = 8 * 64 * 65 * 4;
constexpr int LDSCTL_OFF = 144 * 1024, MISC_OFF = LDSCTL_OFF + 320;
constexpr int LDS_BYTES = 148480;
static_assert(SCR_BYTES <= LDSCTL_OFF && MISC_OFF + 128 <= LDS_BYTES, "LDS map");


#ifndef SINGLE_LAUNCH
#define SINGLE_LAUNCH 1
#endif
constexpr bool MOE_WEIGHTS = true;
constexpr int FAST_PHASES = 13;
constexpr int CW_BAR = 4096;
#define XB_TMO      128
#define XB_XCNT(j)  (256  + 64 * (j))
#define XB_XSUB(j)  (1280 + 64 * (j))
#define XB_XGEN(j)  (2304 + 64 * (j))
#define XB_TOP      3328
#define XB_TOPGEN   3392
#define XCD_BAR_WORDS 3456
#define XB_SPIN_CAP (1u << 18)

__device__ __forceinline__ unsigned xb_ld(unsigned* p)              { return __hip_atomic_load(p, __ATOMIC_RELAXED, __HIP_MEMORY_SCOPE_AGENT); }
__device__ __forceinline__ unsigned xb_add(unsigned* p, unsigned v) { return __hip_atomic_fetch_add(p, v, __ATOMIC_RELAXED, __HIP_MEMORY_SCOPE_AGENT); }
__device__ __forceinline__ unsigned xb_xcc_id() { return (unsigned)__builtin_amdgcn_s_getreg((3 << 11) | 20) & 0xFu; }
#define XB_SPIN(cond, bar) do { unsigned _sp = 0; while (cond) { __builtin_amdgcn_s_sleep(1); \
    if ((++_sp & 255u) == 0u) { if (xb_ld(&(bar)[XB_TMO])) break; if (_sp > XB_SPIN_CAP) { atomicAdd(&(bar)[XB_TMO], 1u); break; } } } } while (0)

struct XcdBarrier {
    unsigned* bar; unsigned x;
    volatile LAS unsigned* st;
};

__device__ __forceinline__ XcdBarrier xcd_barrier_post(unsigned* bar, volatile LAS unsigned* st) {
    XcdBarrier b; b.bar = bar; b.x = xb_xcc_id(); b.st = st;
    if (threadIdx.x == 0) (void)xb_add(&bar[XB_XCNT(b.x)], 1u);
    return b;
}
__device__ __forceinline__ void xcd_barrier_complete(unsigned* bar, unsigned x, unsigned& nloc, unsigned& nx) {
    const unsigned G = gridDim.x * gridDim.y * gridDim.z;
    unsigned sum, cnt, mine, sp = 0u;
    for (;;) {
        sum = 0u; cnt = 0u; mine = 0u;
#pragma unroll
        for (unsigned j = 0; j < 16; ++j) { const unsigned c = xb_ld(&bar[XB_XCNT(j)]); sum += c; cnt += (c > 0u) ? 1u : 0u; mine = (j == x) ? c : mine; }
        if (sum == G) break;
        __builtin_amdgcn_s_sleep(1);
        if ((++sp & 255u) == 0u) { if (xb_ld(&bar[XB_TMO])) break; if (sp > XB_SPIN_CAP) { atomicAdd(&bar[XB_TMO], 1u); break; } }
    }
    nloc = mine > 0u ? mine : 1u; nx = cnt > 0u ? cnt : 1u;
}

__device__ __forceinline__ void xcd_barrier(const XcdBarrier& b) {
    asm volatile("s_waitcnt vmcnt(0)" ::: "memory");
    __syncthreads();
    if (threadIdx.x == 0) {
        unsigned* bar = b.bar;
        __builtin_amdgcn_s_waitcnt(0);
        unsigned nloc = b.st[0], nx = b.st[1];
        if (nloc == 0u) { xcd_barrier_complete(bar, b.x, nloc, nx); b.st[0] = nloc; b.st[1] = nx; }
        const unsigned old = xb_add(&bar[XB_XSUB(b.x)], 1u);
        const unsigned gen = old / nloc;
        if (old + 1u == (gen + 1u) * nloc) {
            __builtin_amdgcn_fence(__ATOMIC_RELEASE, "agent");
            asm volatile("s_waitcnt vmcnt(0)" ::: "memory");
            const unsigned og = xb_add(&bar[XB_TOP], 1u);
            const unsigned tg = og / nx;
            if (og + 1u == (tg + 1u) * nx) xb_add(&bar[XB_TOPGEN], 1u);
            else XB_SPIN(xb_ld(&bar[XB_TOPGEN]) == tg, bar);
            __builtin_amdgcn_fence(__ATOMIC_ACQUIRE, "agent");
            xb_add(&bar[XB_XGEN(b.x)], 1u);
            asm volatile("s_waitcnt vmcnt(0)" ::: "memory");
        } else {
            XB_SPIN(xb_ld(&bar[XB_XGEN(b.x)]) == gen, bar);
            __builtin_amdgcn_fence(__ATOMIC_ACQUIRE, "agent");
            asm volatile("s_waitcnt vmcnt(0)" ::: "memory");
        }
    }
    __syncthreads();
}

namespace pg8 {
#define PG8_LAS __attribute__((address_space(3)))
typedef unsigned short bf16_t;
typedef short bf16x8 __attribute__((ext_vector_type(8)));
typedef float f32x4 __attribute__((ext_vector_type(4)));
typedef unsigned u32x4 __attribute__((ext_vector_type(4)));
constexpr int BM = 256, BK = 64, HALF = 128, HTB = HALF * BK * 2  , STAGE_BYTES = 8 * HTB, NXCD = 8, WGM = 8;

__host__ __device__ __forceinline__ int lds_byte(int r, int c) { const int st = (r >> 4) * 2 + (c >> 5), rr = r & 15, cc = c & 31, ob = rr * 64 + cc * 2; return st * 1024 + (ob ^ (((ob >> 9) & 1) << 5)); }
__host__ __device__ __forceinline__ void stage_rc(int b, int& R, int& C) { const int st = b / 1024, sb = b % 1024, swz = sb ^ (((sb >> 9) & 1) << 5); R = (st >> 1) * 16 + swz / 64; C = (st & 1) * 32 + (swz % 64) / 2; }
__host__ __device__ __forceinline__ int perm32(int rho) { const int n = rho >> 4, i = rho & 15; return 8 * (i >> 2) + 4 * n + (i & 3); }

struct Unit { int pm, pn; };
struct Gemm { const bf16_t* A; const bf16_t* Bt; int M, N, K, lda, ldb; };

struct StaticOrder {
    int nM, nN, nwg, G, c;
    __host__ __device__ void init(int M, int N, int G_, int c_) { nM = M / BM; nN = N / BM; nwg = nM * nN; G = G_; c = c_; }
    __host__ __device__ bool next(int i, Unit& u) const {
        const long L = (long)i * G + c; if (L >= nwg) return false;
        int wgid = (int)L; { const int q = nwg / NXCD, r = nwg % NXCD, xcd = wgid % NXCD, off = wgid / NXCD; wgid = (xcd < r ? xcd * (q + 1) : r * (q + 1) + (xcd - r) * q) + off; }
        const int nig = WGM * nN, gid = wgid / nig, fm = gid * WGM, gsz = (nM - fm) < WGM ? (nM - fm) : WGM;
        u.pm = fm + ((wgid % nig) % gsz); u.pn = (wgid % nig) / gsz; return true;
    }
    __device__ __forceinline__ void a_ready(const Unit&) const {}
    __device__ __forceinline__ void done(const Unit&) const {}
};

__device__ __forceinline__ unsigned cvt_pk_bf16(float lo, float hi) { unsigned r; asm volatile("v_cvt_pk_bf16_f32 %0, %1, %2" : "=v"(r) : "v"(lo), "v"(hi)); return r; }
typedef int i32x8 __attribute__((ext_vector_type(8)));
template <class Epi, class Sched, bool ALIGN_EPI = false, bool SP2 = false, bool FP8 = false>
__device__ __forceinline__ void gemm_phase(PG8_LAS unsigned char* lds, const Gemm g, const Sched& S, const Epi& E) {
    int tid_ = threadIdx.x; asm volatile("" : "+v"(tid_));
    const int tid = tid_, wid = __builtin_amdgcn_readfirstlane(tid >> 6), lane = tid & 63, wr = wid >> 2, wc = wid & 3, fr = lane & 15, fq = lane >> 4;
    int K_ = g.K; asm volatile("" : "+s"(K_));
    const int K = K_, nt = K / BK;
    unsigned voffA[2], voffB[2];
#pragma unroll
    for (int i = 0; i < 2; ++i) { int R, C; stage_rc(tid * 16 + i * 8192, R, C); const int Rb = Epi::PERM ? ((R & ~31) + perm32(R & 31)) : R;
        voffA[i] = (unsigned)(R * g.lda + C) * 2u; voffB[i] = (unsigned)(Rb * g.ldb + C) * 2u; }
    const size_t kstep = (size_t)(BK * 2);
    const size_t hstepA = (size_t)HALF * g.lda * 2, hstepB = (size_t)HALF * g.ldb * 2;
    const size_t tstepA = 2 * hstepA, tstepB = 2 * hstepB;
    const unsigned ldsw = (unsigned)wid * 1024u;
    const int aoff = lds_byte(wr * 64 + fr, fq * 8), boff = lds_byte(wc * 32 + fr, fq * 8);
#define PG8_SA(b, h) (((b) * 2 + (h)) * HTB)
#define PG8_SB(b, h) ((4 + (b) * 2 + (h)) * HTB)
#define PG8_STAGE(bufoff, gbase, voff) do { _Pragma("unroll") for (int _i = 0; _i < 2; ++_i) \
        __builtin_amdgcn_global_load_lds((const unsigned*)((const char*)(gbase) + (voff)[_i]), (PG8_LAS unsigned*)(lds + (bufoff) + ldsw + _i * 8192), 16, 0, 0); } while (0)
#define PG8_LDA(dst, b, h) do { _Pragma("unroll") for (int m = 0; m < 4; ++m) _Pragma("unroll") for (int k = 0; k < 2; ++k) dst[m][k] = *(const PG8_LAS bf16x8*)(lds + PG8_SA(b, h) + aoff + m * 2048 + k * 1024); } while (0)
#define PG8_LDB(dst, b, h) do { _Pragma("unroll") for (int n = 0; n < 2; ++n) _Pragma("unroll") for (int k = 0; k < 2; ++k) dst[n][k] = *(const PG8_LAS bf16x8*)(lds + PG8_SB(b, h) + boff + n * 2048 + k * 1024); } while (0)
#define PG8_CAT(X) __builtin_bit_cast(i32x8, __builtin_shufflevector(X[0], X[1], 0, 1, 2, 3, 4, 5, 6, 7, 8, 9, 10, 11, 12, 13, 14, 15))
#define PG8_MMA(ai, bj, At, Bt) do { __builtin_amdgcn_s_setprio(1); \
        if constexpr (FP8) { _Pragma("unroll") for (int m = 0; m < 4; ++m) _Pragma("unroll") for (int n = 0; n < 2; ++n) \
            asm volatile("s_nop 1\n\tv_mfma_scale_f32_16x16x128_f8f6f4 %0, %1, %2, %0, %3, %4 op_sel_hi:[0,0,0]" : "+v"(acc[ai][bj][m][n]) : "v"(PG8_CAT(Bt[n])), "v"(PG8_CAT(At[m])), "v"(sc_w8), "v"(sc_one)); } \
        else { _Pragma("unroll") for (int m = 0; m < 4; ++m) _Pragma("unroll") for (int n = 0; n < 2; ++n) _Pragma("unroll") for (int k = 0; k < 2; ++k) \
            acc[ai][bj][m][n] = __builtin_amdgcn_mfma_f32_16x16x32_bf16(Bt[n][k], At[m][k], acc[ai][bj][m][n], 0, 0, 0); } \
        __builtin_amdgcn_s_setprio(0); } while (0)
#define PG8_WAIT_V(n) asm volatile("s_waitcnt vmcnt(" #n ")" ::: "memory")
#define PG8_WAIT_L(n) asm volatile("s_waitcnt lgkmcnt(" #n ")" ::: "memory")
#define PG8_BAR __builtin_amdgcn_s_barrier()
#define PG8_SCHED __builtin_amdgcn_sched_barrier(0)
    int sc_w8 = W8_E8M0, sc_one = ONE_E8M0; asm volatile("" : "+v"(sc_w8), "+v"(sc_one));
    Unit cur, nxt; int ui = 0;
    if (!S.next(0, cur)) return;
    f32x4 acc[2][2][4][2];
#pragma unroll
    for (int a = 0; a < 2; ++a)
#pragma unroll
        for (int b = 0; b < 2; ++b)
#pragma unroll
            for (int m = 0; m < 4; ++m)
#pragma unroll
                for (int n = 0; n < 2; ++n) acc[a][b][m][n] = (f32x4){0.f, 0.f, 0.f, 0.f};
    bf16x8 At[4][2], B0[2][2], B1[2][2];
    const char* cA = (const char*)g.A + (size_t)cur.pm * tstepA; const char* cB = (const char*)g.Bt + (size_t)cur.pn * tstepB;
    S.a_ready(cur);
    if constexpr (SP2) {
        PG8_STAGE(PG8_SB(0, 0), cB, voffB); PG8_STAGE(PG8_SB(0, 1), cB + hstepB, voffB); PG8_STAGE(PG8_SA(0, 0), cA, voffA); PG8_STAGE(PG8_SA(0, 1), cA + hstepA, voffA);
        if (wr == 1) PG8_BAR;
        PG8_WAIT_V(2); PG8_BAR;
        PG8_STAGE(PG8_SB(1, 0), cB + kstep, voffB); PG8_STAGE(PG8_SA(1, 0), cA + kstep, voffA); PG8_STAGE(PG8_SB(1, 1), cB + hstepB + kstep, voffB);
        PG8_WAIT_V(6); PG8_BAR;
    } else {
        PG8_STAGE(PG8_SB(0, 0), cB, voffB); PG8_STAGE(PG8_SA(0, 0), cA, voffA); PG8_STAGE(PG8_SB(0, 1), cB + hstepB, voffB); PG8_STAGE(PG8_SA(0, 1), cA + hstepA, voffA);
        if (wr == 1) PG8_BAR;
        PG8_WAIT_V(4); PG8_BAR;
        PG8_STAGE(PG8_SB(1, 0), cB + kstep, voffB); PG8_STAGE(PG8_SA(1, 0), cA + kstep, voffA); PG8_STAGE(PG8_SB(1, 1), cB + hstepB + kstep, voffB);
        PG8_WAIT_V(6); PG8_BAR;
    }
    for (;;) {
        const bool has_next = S.next(ui + 1, nxt);
        const char* nA = has_next ? (const char*)g.A + (size_t)nxt.pm * tstepA : cA; const char* nB = has_next ? (const char*)g.Bt + (size_t)nxt.pn * tstepB : cB;
        for (int t = 0; t < nt; t += 2) {
            const bool last = (t == nt - 2);
            const char* a1 = cA + (size_t)(t + 1) * kstep;
            const char* a2 = last ? nA : cA + (size_t)(t + 2) * kstep; const char* b2 = last ? nB : cB + (size_t)(t + 2) * kstep;
            const char* a3 = a2 + kstep; const char* b3 = b2 + kstep;
            if (last && has_next) S.a_ready(nxt);
            if constexpr (SP2) {
            PG8_LDB(B0, 0, 0); PG8_LDB(B1, 0, 1); PG8_SCHED; PG8_LDA(At, 0, 0); PG8_STAGE(PG8_SA(1, 1), a1 + hstepA, voffA);
            PG8_WAIT_V(8); PG8_WAIT_L(0); PG8_BAR; PG8_MMA(0, 0, At, B0); PG8_MMA(0, 1, At, B1); PG8_BAR; PG8_SCHED;
            PG8_LDA(At, 0, 1); PG8_STAGE(PG8_SB(0, 0), b2, voffB); PG8_STAGE(PG8_SB(0, 1), b2 + hstepB, voffB); PG8_STAGE(PG8_SA(0, 0), a2, voffA);
            PG8_WAIT_V(8); PG8_WAIT_L(0); PG8_BAR; PG8_MMA(1, 0, At, B0); PG8_MMA(1, 1, At, B1); PG8_BAR; PG8_SCHED;
            PG8_LDB(B0, 1, 0); PG8_LDB(B1, 1, 1); PG8_SCHED; PG8_LDA(At, 1, 0); PG8_STAGE(PG8_SA(0, 1), a2 + hstepA, voffA);
            PG8_WAIT_V(8); PG8_WAIT_L(0); PG8_BAR; PG8_MMA(0, 0, At, B0); PG8_MMA(0, 1, At, B1); PG8_BAR; PG8_SCHED;
            PG8_LDA(At, 1, 1); PG8_STAGE(PG8_SB(1, 0), b3, voffB); PG8_STAGE(PG8_SB(1, 1), b3 + hstepB, voffB); PG8_STAGE(PG8_SA(1, 0), a3, voffA);
            PG8_WAIT_V(8); PG8_WAIT_L(0); PG8_BAR; PG8_MMA(1, 0, At, B0); PG8_MMA(1, 1, At, B1); PG8_BAR; PG8_SCHED;
            } else {
            PG8_LDB(B0, 0, 0); PG8_SCHED; PG8_LDA(At, 0, 0); PG8_STAGE(PG8_SA(1, 1), a1 + hstepA, voffA);
            PG8_WAIT_L(8); PG8_BAR; PG8_WAIT_L(0); PG8_MMA(0, 0, At, B0); PG8_BAR; PG8_SCHED;
            PG8_LDB(B1, 0, 1); PG8_STAGE(PG8_SB(0, 0), b2, voffB);
            PG8_BAR; PG8_WAIT_L(0); PG8_MMA(0, 1, At, B1); PG8_BAR;
            PG8_LDA(At, 0, 1); PG8_STAGE(PG8_SA(0, 0), a2, voffA);
            PG8_BAR; PG8_WAIT_L(0); PG8_MMA(1, 0, At, B0); PG8_BAR; PG8_SCHED;
            PG8_STAGE(PG8_SB(0, 1), b2 + hstepB, voffB);
            PG8_WAIT_V(6); PG8_BAR; PG8_MMA(1, 1, At, B1); PG8_BAR;
            PG8_LDB(B0, 1, 0); PG8_SCHED; PG8_LDA(At, 1, 0); PG8_STAGE(PG8_SA(0, 1), a2 + hstepA, voffA);
            PG8_WAIT_L(8); PG8_BAR; PG8_WAIT_L(0); PG8_MMA(0, 0, At, B0); PG8_BAR; PG8_SCHED;
            PG8_LDB(B1, 1, 1); PG8_STAGE(PG8_SB(1, 0), b3, voffB);
            PG8_BAR; PG8_WAIT_L(0); PG8_MMA(0, 1, At, B1); PG8_BAR;
            PG8_LDA(At, 1, 1); PG8_STAGE(PG8_SA(1, 0), a3, voffA);
            PG8_BAR; PG8_WAIT_L(0); PG8_MMA(1, 0, At, B0); PG8_BAR; PG8_SCHED;
            PG8_STAGE(PG8_SB(1, 1), b3 + hstepB, voffB);
            PG8_WAIT_V(6); PG8_BAR; PG8_MMA(1, 1, At, B1); PG8_BAR;
            }
        }
        if constexpr (ALIGN_EPI) { if (wr == 0) PG8_BAR; }
        if constexpr (FP8) asm volatile("s_nop 15\n\ts_nop 7" ::: "memory");
        if constexpr (!Epi::AFTER_DRAIN) { E(acc, cur, wr, wc, fr, fq); S.done(cur); }
        if (!has_next) break;
#pragma unroll
        for (int a = 0; a < 2; ++a)
#pragma unroll
            for (int b = 0; b < 2; ++b)
#pragma unroll
                for (int m = 0; m < 4; ++m)
#pragma unroll
                    for (int n = 0; n < 2; ++n) acc[a][b][m][n] = (f32x4){0.f, 0.f, 0.f, 0.f};
        cur = nxt; cA = nA; cB = nB; ++ui;
        if constexpr (ALIGN_EPI) { if (wr == 1) PG8_BAR; }
    }
    PG8_WAIT_V(0);
    if constexpr (!ALIGN_EPI) { if (wr == 0) PG8_BAR; }
    PG8_BAR;
    if constexpr (Epi::AFTER_DRAIN) { E.fused(acc, cur, wr, wc, fr, fq, lds, wid, lane); S.done(cur); }
#undef PG8_SA
#undef PG8_SB
#undef PG8_STAGE
#undef PG8_LDA
#undef PG8_LDB
#undef PG8_MMA
#undef PG8_CAT
#undef PG8_WAIT_V
#undef PG8_WAIT_L
#undef PG8_BAR
#undef PG8_SCHED
}
}


template <int MAP> __device__ __forceinline__ int conv_map(int n) {
    if (MAP == 1) return n >= 416 ? n + 96 : n;
    if (MAP == 2) { const int j = n & 1023; return 256 * (j >> 7) + (j & 127) + ((n >> 10) << 7); }
    return n;
}
template <int MAP, bool FP8> __device__ __forceinline__ void conv_item(const float* W, int ldsrc, int N, int k0, int n0, void* dstv, int ldd, const float* gain, int glim,
                                                             LAS float* scr, int lane) {
    const int kr = lane >> 4, nc = (lane & 15) * 4;
    f32x4 v[16];
#pragma unroll
    for (int i = 0; i < 16; ++i) {
        const int kk = 4 * i + kr;
        if (n0 + nc < N) v[i] = *(const GAS f32x4*)(W + (size_t)(k0 + kk) * ldsrc + n0 + nc); else v[i] = (f32x4){0.f, 0.f, 0.f, 0.f};
    }
#pragma unroll
    for (int i = 0; i < 16; ++i) {
        const int kk = 4 * i + kr;
        float gs = FP8 ? W8_SCALE : 1.f; if (gain && (k0 + kk) < glim) gs *= gain[k0 + kk];
        LAS float* s = scr + kk * 65 + nc;
        s[0] = v[i].x * gs; s[1] = v[i].y * gs; s[2] = v[i].z * gs; s[3] = v[i].w * gs;
    }
    LDS_WAIT(); asm volatile("" ::: "memory");
    const int c = lane & 7;
#pragma unroll
    for (int j = 0; j < 8; ++j) {
        const int n = (lane >> 3) + 8 * j; const LAS float* s = scr + (8 * c) * 65 + n;
        if (FP8) {
            v2u o; o.x = pk4_fp8(s[0 * 65], s[1 * 65], s[2 * 65], s[3 * 65]); o.y = pk4_fp8(s[4 * 65], s[5 * 65], s[6 * 65], s[7 * 65]);
            if (n0 + n < N) *(GAS v2u*)((unsigned char*)dstv + (size_t)conv_map<MAP>(n0 + n) * ldd + k0 + 8 * c) = o;
        } else {
            v4u o; o.x = pk2(s[0 * 65], s[1 * 65]); o.y = pk2(s[2 * 65], s[3 * 65]); o.z = pk2(s[4 * 65], s[5 * 65]); o.w = pk2(s[6 * 65], s[7 * 65]);
            if (n0 + n < N) *(GAS v4u*)((bf16*)dstv + (size_t)conv_map<MAP>(n0 + n) * ldd + k0 + 8 * c) = o;
        }
    }
    LDS_WAIT(); asm volatile("" ::: "memory");
}

struct Args { const float* in[28]; float* out; unsigned char* ws; int ph_lo, ph_hi; };
struct Frame {
    LAS unsigned char* lds;
    volatile LAS unsigned* MISC;
    gu32* ctl;
    int tid, lane, wave;
    int vcu, G;
    unsigned char* ws;
    float* out;
};

template <bool MOE_W> __device__ __forceinline__ void p0_prologue(Frame& F, const Args& A) {
    LAS float* scr = (LAS float*)(F.lds) + F.wave * (64 * 65);
    const int gw = F.vcu * NWAVES + F.wave, NGW = F.G * NWAVES;
    unsigned char* ws = F.ws;
    constexpr int I_IN = 16 * 23, I_UQ = 4 * 12, I_UKV = 2 * 16, I_R = 16, I_OUT = 256, I_PG = 256, I_PP = 4 * 16;
    constexpr int I_GU = 32 * 16 * 32, I_D = 32 * 16 * 16;
    constexpr int NSMALL = I_IN + I_UQ + I_UKV + I_R + I_OUT + I_PG + I_PP;
    constexpr int NITEMS = NSMALL + (MOE_W ? I_GU + I_D : 0);
    for (int it = gw; it < NITEMS; it += NGW) {
        int r = it;
        if (MOE_W) {
            if (r < I_GU) { const int e = r >> 9, rr = r & 511, kb = rr >> 5, nb = rr & 31;
                conv_item<2, true>(A.in[19] + (size_t)e * DM * 2048, 2048, 2048, kb * 64, nb * 64, ws + WS_WGU + (size_t)e * 2048 * 1024, 1024, A.in[16], 1024, scr, F.lane); continue; }
            r -= I_GU;
            if (r < I_D) { const int e = r >> 8, rr = r & 255, kb = rr >> 4, nb = rr & 15;
                conv_item<0, true>(A.in[21] + (size_t)e * DE * DM, 1024, 1024, kb * 64, nb * 64, ws + WS_WD + (size_t)e * 1024 * 1024, 1024, nullptr, 0, scr, F.lane); continue; }
            r -= I_D;
        }
        if (r < I_IN) { conv_item<1, false>(A.in[4], IN_COLS, IN_COLS, (r / 23) * 64, (r % 23) * 64, (bf16*)(ws + WS_WIN), 1024, A.in[3], 1024, scr, F.lane); continue; } r -= I_IN;
        if (r < I_UQ) { conv_item<0, false>(A.in[6], 768, 768, (r / 12) * 64, (r % 12) * 64, (bf16*)(ws + WS_WUQ), 256, A.in[5], 256, scr, F.lane); continue; } r -= I_UQ;
        if (r < I_UKV) { conv_item<0, false>(A.in[8], 1024, 1024, (r / 16) * 64, (r % 16) * 64, (bf16*)(ws + WS_WUKV), 128, A.in[7], 128, scr, F.lane); continue; } r -= I_UKV;
        if (r < I_R) { conv_item<0, false>(A.in[17], 32, 32, r * 64, 0, (bf16*)(ws + WS_WR), 1024, A.in[16], 1024, scr, F.lane); continue; } r -= I_R;
        if (r < I_OUT) { conv_item<0, false>(A.in[14], 1024, 1024, (r >> 4) * 64, (r & 15) * 64, (bf16*)(ws + WS_WOUT), 1024, A.in[12], 512, scr, F.lane); continue; } r -= I_OUT;
        if (r < I_PG) { conv_item<0, false>(A.in[24], 1024, 1024, (r >> 4) * 64, (r & 15) * 64, (bf16*)(ws + WS_WPG), 1024, nullptr, 0, scr, F.lane); continue; } r -= I_PG;
        conv_item<0, false>(A.in[26], 1024, 1024, (r >> 4) * 64, (r & 15) * 64, (bf16*)(ws + WS_WPP), 256, nullptr, 0, scr, F.lane);
    }
    const float* x = A.in[0]; const float* p = A.in[1]; const int* pos = (const int*)A.in[2];
    bf16* xb = (bf16*)(ws + WS_XB); bf16* pb = (bf16*)(ws + WS_PB); float* rstdx = (float*)(ws + WS_RSTDX); f32x2* rope = (f32x2*)(ws + WS_ROPE);
    for (int m = gw; m < M; m += NGW) {
        const GAS f32x4* xr = (const GAS f32x4*)(x + (size_t)m * DM) + F.lane;
        f32x4 v[4]; float s = 0.f;
#pragma unroll
        for (int j = 0; j < 4; ++j) { v[j] = xr[64 * j]; s += (v[j].x * v[j].x + v[j].y * v[j].y) + (v[j].z * v[j].z + v[j].w * v[j].w); }
        s = wave_sum(s);
        GAS v2u* o8 = (GAS v2u*)(xb + (size_t)m * DM) + F.lane;
#pragma unroll
        for (int j = 0; j < 4; ++j) { v2u w; w.x = pk2(v[j].x, v[j].y); w.y = pk2(v[j].z, v[j].w); o8[64 * j] = w; }
        const f32x4 pv = *((const GAS f32x4*)(p + (size_t)m * DPLE) + F.lane);
        { v2u w; w.x = pk2(pv.x, pv.y); w.y = pk2(pv.z, pv.w); *((GAS v2u*)(pb + (size_t)m * DPLE) + F.lane) = w; }
        if (F.lane == 0) rstdx[m] = rsqrtf(s * (1.f / DM) + EPS);
        if (F.lane < 16) {
            const float inv_freq = 1.0f / powf(10000.0f, (float)(2 * F.lane) / 32.0f);
            const float ang = (float)pos[m] * inv_freq;
            rope[(size_t)m * 16 + F.lane] = (f32x2){cosf(ang), sinf(ang)};
        }
    }
}

namespace pg8 {
struct EpiZ {
    static constexpr bool PERM = true, AFTER_DRAIN = false;
    bf16_t* Z; const float* rstdx; float* qpart; float* kvpart;
    __device__ __forceinline__ void operator()(const f32x4 (&acc)[2][2][4][2], const Unit& u, int wr, int wc, int fr, int fq) const {
        const int row0 = u.pm * BM + wr * 64 + fr, col0 = u.pn * BM + wc * 32 + 8 * fq;
#pragma unroll
        for (int ai = 0; ai < 2; ++ai)
#pragma unroll
            for (int m = 0; m < 4; ++m) {
                const int row = row0 + ai * HALF + m * 16; const float rs = rstdx[row]; float ss[2];
#pragma unroll
                for (int bj = 0; bj < 2; ++bj) {
                    const f32x4 v0 = acc[ai][bj][m][0] * rs, v1 = acc[ai][bj][m][1] * rs;
                    u32x4 w; w.x = cvt_pk_bf16(v0[0], v0[1]); w.y = cvt_pk_bf16(v0[2], v0[3]); w.z = cvt_pk_bf16(v1[0], v1[1]); w.w = cvt_pk_bf16(v1[2], v1[3]);
                    *(u32x4*)(Z + (size_t)row * 1536 + col0 + bj * HALF) = w;
                    ss[bj] = (v0[0] * v0[0] + v0[1] * v0[1]) + (v0[2] * v0[2] + v0[3] * v0[3]) + (v1[0] * v1[0] + v1[1] * v1[1]) + (v1[2] * v1[2] + v1[3] * v1[3]);
                }
                if (u.pn < 2) {
                    float s = (u.pn == 0) ? ss[0] + ss[1] : ss[0];
                    s += __shfl_xor(s, 16); s += __shfl_xor(s, 32);
                    if (fq == 0) { float* dst = (u.pn == 0) ? qpart : kvpart; dst[row * 4 + wc] = s; }
                }
            }
    }
};
struct EpiQ {
    static constexpr bool PERM = false, AFTER_DRAIN = false;
    bf16_t* Q; const float* qpart; const f32x2* rope;
    __device__ __forceinline__ void operator()(const f32x4 (&acc)[2][2][4][2], const Unit& u, int wr, int wc, int fr, int fq) const {
        const int row0 = u.pm * BM + wr * 64 + fr;
#pragma unroll
        for (int ai = 0; ai < 2; ++ai)
#pragma unroll
            for (int m = 0; m < 4; ++m) {
                const int row = row0 + ai * HALF + m * 16;
                const f32x4 qp = *(const f32x4*)(qpart + row * 4);
                const float rs = rsqrtf(((qp[0] + qp[1]) + (qp[2] + qp[3])) * (1.f / 256.f) + EPS) * C2Q;
#pragma unroll
                for (int bj = 0; bj < 2; ++bj) {
                    const int gb = u.pn * BM + bj * HALF + wc * 32;
                    f32x4 a = acc[ai][bj][m][0] * rs, b = acc[ai][bj][m][1] * rs;
                    if ((gb >> 5) % 3 == 2) {
                        const f32x2* cs = rope + (size_t)row * 16 + 4 * fq;
                        f32x4 oa, ob;
#pragma unroll
                        for (int i = 0; i < 4; ++i) { const f32x2 c = cs[i]; oa[i] = a[i] * c.x - b[i] * c.y; ob[i] = b[i] * c.x + a[i] * c.y; }
                        a = oa; b = ob;
                    }
                    v2u w0, w1; w0.x = cvt_pk_bf16(a[0], a[1]); w0.y = cvt_pk_bf16(a[2], a[3]); w1.x = cvt_pk_bf16(b[0], b[1]); w1.y = cvt_pk_bf16(b[2], b[3]);
                    *(v2u*)(Q + (size_t)row * 768 + gb + 4 * fq) = w0;
                    *(v2u*)(Q + (size_t)row * 768 + gb + 16 + 4 * fq) = w1;
                }
                asm volatile("" ::: "memory");
            }
    }
};
struct EpiKV {
    static constexpr bool PERM = true, AFTER_DRAIN = false;
    bf16_t* Kb; bf16_t* Vb; const float* kvpart;
    __device__ __forceinline__ void operator()(const f32x4 (&acc)[2][2][4][2], const Unit& u, int wr, int wc, int fr, int fq) const {
        const int row0 = u.pm * BM + wr * 64 + fr, d = wc * 32 + 8 * fq;
#pragma unroll
        for (int ai = 0; ai < 2; ++ai)
#pragma unroll
            for (int m = 0; m < 4; ++m) {
                const int row = row0 + ai * HALF + m * 16;
                const f32x4 qp = *(const f32x4*)(kvpart + row * 4);
                const float rs = rsqrtf(((qp[0] + qp[1]) + (qp[2] + qp[3])) * (1.f / 128.f) + EPS);
#pragma unroll
                for (int bj = 0; bj < 2; ++bj) {
                    const int h = 2 * u.pn + bj;
                    const f32x4 v0 = acc[ai][bj][m][0] * rs, v1 = acc[ai][bj][m][1] * rs;
                    u32x4 w; w.x = cvt_pk_bf16(v0[0], v0[1]); w.y = cvt_pk_bf16(v0[2], v0[3]); w.z = cvt_pk_bf16(v1[0], v1[1]); w.w = cvt_pk_bf16(v1[2], v1[3]);
                    bf16_t* dst = (d < 64) ? Kb + (size_t)row * 768 + h * 96 + d : Vb + (size_t)row * 512 + h * 64 + (d - 64);
                    *(u32x4*)dst = w;
                }
                asm volatile("" ::: "memory");
            }
    }
};
struct EpiStore {
    static constexpr bool PERM = true, AFTER_DRAIN = false;
    bf16_t* O; int ldc; const float* rowscale;
    __device__ __forceinline__ void operator()(const f32x4 (&acc)[2][2][4][2], const Unit& u, int wr, int wc, int fr, int fq) const {
        const int row0 = u.pm * BM + wr * 64 + fr, col0 = u.pn * BM + wc * 32 + 8 * fq;
#pragma unroll
        for (int ai = 0; ai < 2; ++ai)
#pragma unroll
            for (int m = 0; m < 4; ++m) {
                const int row = row0 + ai * HALF + m * 16; const float rs = rowscale ? rowscale[row] : 1.f;
#pragma unroll
                for (int bj = 0; bj < 2; ++bj) {
                    const f32x4 v0 = acc[ai][bj][m][0] * rs, v1 = acc[ai][bj][m][1] * rs;
                    u32x4 w; w.x = cvt_pk_bf16(v0[0], v0[1]); w.y = cvt_pk_bf16(v0[2], v0[3]); w.z = cvt_pk_bf16(v1[0], v1[1]); w.w = cvt_pk_bf16(v1[2], v1[3]);
                    *(u32x4*)(O + (size_t)row * ldc + col0 + bj * HALF) = w;
                }
            }
    }
};
}

__device__ __forceinline__ void p2_krope(Frame& F) {
    const int gw = F.vcu * NWAVES + F.wave, NGW = F.G * NWAVES;
    const bf16* z = (const bf16*)(F.ws + WS_Z); bf16* Kb = (bf16*)(F.ws + WS_K); const f32x2* rope = (const f32x2*)(F.ws + WS_ROPE);
    for (int m0 = gw * 4; m0 < M; m0 += NGW * 4) {
        const int row = m0 + (F.lane >> 4), j = F.lane & 15;
        const float x1 = bf2f(z[(size_t)row * ZLD + ZC_KR + j]), x2 = bf2f(z[(size_t)row * ZLD + ZC_KR + 16 + j]);
        const f32x2 c = rope[(size_t)row * 16 + j];
        const bf16 o1 = (bf16)f2bf(x1 * c.x - x2 * c.y), o2 = (bf16)f2bf(x2 * c.x + x1 * c.y);
#pragma unroll
        for (int h = 0; h < NH; ++h) { Kb[(size_t)row * KLD + h * DQK + 64 + j] = o1; Kb[(size_t)row * KLD + h * DQK + 80 + j] = o2; }
    }
}

namespace att {
constexpr int NW = 8, QBLK = 32, KVBLK = 64, QB = NW * QBLK;
constexpr int SHM_V = KVBLK * DV * 2;
constexpr int SHM_K = KVBLK * 256;
constexpr int LDS_BYTES_ATT = 2 * SHM_V + 2 * SHM_K + NW * 64 * 4;
#define KSWZ(row, colB) ((row) * 256 + ((colB) ^ (((row) & 7) << 4)))
#define SBAR() __builtin_amdgcn_sched_barrier(0)
__device__ __forceinline__ int v_st(int k, int c) { const int kk = (k & ~0xC) | ((k & 4) << 1) | ((k & 8) >> 1); return ((kk >> 3) * 2 + (c >> 5)) * 512 + ((kk & 7) * 32 + (c & 31)) * 2; }
__device__ __forceinline__ int v_rd_base(int lane) { return ((lane & 3) << 3) | (((lane >> 2) & 3) << 6) | (((lane >> 4) & 1) << 5) | (((lane >> 5) & 1) << 8); }
__device__ __forceinline__ int crow(int r, int hi) { return (r & 3) + 8 * (r >> 2) + 4 * hi; }
__device__ __forceinline__ unsigned cvtpk(float lo, float hi) { unsigned r; asm volatile("v_cvt_pk_bf16_f32 %0, %1, %2" : "=v"(r) : "v"(lo), "v"(hi)); return r; }

__device__ __forceinline__ void mask_tile(f32x16& p0, f32x16& p1, int dq) {
    const float NEG = -__builtin_inff();
#pragma unroll
    for (int r = 0; r < 16; ++r) {
        const int c = (r & 3) + 8 * (r >> 2);
        if (dq - c < 0) p0[r] = NEG;
        if (dq - c - 32 < 0) p1[r] = NEG;
    }
}
constexpr float THRL = 8.f;
__device__ __forceinline__ void partialSM(f32x16& p0, f32x16& p1, float& m_reg, float& alpha) {
    float pmax = p0[0];
#pragma unroll
    for (int r = 1; r < 16; ++r) pmax = fmaxf(pmax, p0[r]);
#pragma unroll
    for (int r = 0; r < 16; ++r) pmax = fmaxf(pmax, p1[r]);
    { auto rr = __builtin_amdgcn_permlane32_swap(__float_as_uint(pmax), __float_as_uint(pmax), false, false);
      pmax = fmaxf(__uint_as_float(rr[0]), __uint_as_float(rr[1])); }
    float mn;
    if (__builtin_expect(__all((pmax - m_reg) <= THRL), 1)) { mn = m_reg; alpha = 1.f; }
    else { mn = fmaxf(m_reg, pmax); alpha = __builtin_amdgcn_exp2f(m_reg - mn); m_reg = mn; }
#pragma unroll
    for (int r = 0; r < 16; ++r) p0[r] = p0[r] - mn;
#pragma unroll
    for (int r = 0; r < 16; ++r) p1[r] = p1[r] - mn;
#pragma unroll
    for (int r = 0; r < 16; ++r) p0[r] = __builtin_amdgcn_exp2f(p0[r]);
}
__device__ __forceinline__ void finishSM(f32x16& p0, f32x16& p1, float alpha, float& l_reg, bf16x8& pa0, bf16x8& pa1, bf16x8& pa2, bf16x8& pa3) {
#pragma unroll
    for (int r = 0; r < 16; ++r) p1[r] = __builtin_amdgcn_exp2f(p1[r]);
    float ps = 0;
#pragma unroll
    for (int r = 0; r < 16; ++r) ps += p0[r];
#pragma unroll
    for (int r = 0; r < 16; ++r) ps += p1[r];
    { auto rr = __builtin_amdgcn_permlane32_swap(__float_as_uint(ps), __float_as_uint(ps), false, false);
      ps = __uint_as_float(rr[0]) + __uint_as_float(rr[1]); }
    l_reg = l_reg * alpha + ps;
#define PK4(P, B_, OUT) do { unsigned a0 = cvtpk(P[B_+0], P[B_+1]), a1 = cvtpk(P[B_+2], P[B_+3]);                          \
        unsigned b0 = cvtpk(P[B_+4], P[B_+5]), b1 = cvtpk(P[B_+6], P[B_+7]);                                             \
        auto r0 = __builtin_amdgcn_permlane32_swap(a0, b0, false, false); auto r1 = __builtin_amdgcn_permlane32_swap(a1, b1, false, false); \
        v4u w = {r0[0], r1[0], r0[1], r1[1]}; OUT = __builtin_bit_cast(bf16x8, w); } while (0)
    PK4(p0, 0, pa0); PK4(p0, 8, pa1); PK4(p1, 0, pa2); PK4(p1, 8, pa3);
#undef PK4
}
template <int KB>
__device__ __forceinline__ void qkt(f32x16& p0, f32x16& p1, const char* K_lds, int r32, int hi, const bf16x8* qr) {
    p0 = f32x16{}; p1 = f32x16{};
    const char* kb[2];
#pragma unroll
    for (int dd = 0; dd < 2; ++dd) kb[dd] = K_lds + KB * SHM_K + KSWZ(r32, (dd * 16 + hi * 8) * 2);
    const char* kb2[2];
#pragma unroll
    for (int dd = 0; dd < 2; ++dd) kb2[dd] = K_lds + KB * SHM_K + KSWZ(r32, ((dd + 2) * 16 + hi * 8) * 2);
#pragma unroll
    for (int d0 = 0; d0 < 6; ++d0) {
        const char* a = (d0 & 2) ? kb2[d0 & 1] + (d0 >> 2) * 128 : kb[d0 & 1] + (d0 >> 2) * 128;
        bf16x8 b0 = *reinterpret_cast<const bf16x8*>(a);
        bf16x8 b1 = *reinterpret_cast<const bf16x8*>(a + 32 * 256);
        p0 = __builtin_amdgcn_mfma_f32_32x32x16_bf16(b0, qr[d0], p0, 0, 0, 0);
        p1 = __builtin_amdgcn_mfma_f32_32x32x16_bf16(b1, qr[d0], p1, 0, 0, 0);
    }
}
template <int VB>
__device__ __forceinline__ void pv_tile(f32x16* o, int vb0, bf16x8 pa0, bf16x8 pa1, bf16x8 pa2, bf16x8 pa3) {
#define TRRD(dst, off) asm volatile("ds_read_b64_tr_b16 %0, %1 offset:%2" : "=&v"(dst) : "v"(vb0), "i"(off) : "memory")
#define PV_D0(d0) do { s16x4 l0, l1, l2, l3, h0, h1, h2, h3; constexpr int b_ = VB * SHM_V + (d0) * 512;     \
        TRRD(l0, b_); TRRD(h0, b_ + 1024); TRRD(l1, b_ + 2048); TRRD(h1, b_ + 3072); TRRD(l2, b_ + 4096); TRRD(h2, b_ + 5120); TRRD(l3, b_ + 6144); TRRD(h3, b_ + 7168); \
        asm volatile("s_waitcnt lgkmcnt(0)" ::: "memory"); SBAR();   \
        o[d0] = __builtin_amdgcn_mfma_f32_32x32x16_bf16(pa0, (bf16x8){l0[0], l0[1], l0[2], l0[3], h0[0], h0[1], h0[2], h0[3]}, o[d0], 0, 0, 0);   \
        o[d0] = __builtin_amdgcn_mfma_f32_32x32x16_bf16(pa1, (bf16x8){l1[0], l1[1], l1[2], l1[3], h1[0], h1[1], h1[2], h1[3]}, o[d0], 0, 0, 0);   \
        o[d0] = __builtin_amdgcn_mfma_f32_32x32x16_bf16(pa2, (bf16x8){l2[0], l2[1], l2[2], l2[3], h2[0], h2[1], h2[2], h2[3]}, o[d0], 0, 0, 0);   \
        o[d0] = __builtin_amdgcn_mfma_f32_32x32x16_bf16(pa3, (bf16x8){l3[0], l3[1], l3[2], l3[3], h3[0], h3[1], h3[2], h3[3]}, o[d0], 0, 0, 0); } while (0)
    PV_D0(0); PV_D0(1);
#undef PV_D0
#undef TRRD
}

__device__ __forceinline__ void attn_block(const bf16* Qp, const bf16* Kp, const bf16* Vp, bf16* Op, int OLD, int P0, char* lds) {
    int tid_ = threadIdx.x; asm volatile("" : "+v"(tid_));
    const int tid = tid_, wid = __builtin_amdgcn_readfirstlane(tid >> 6), lane = tid & 63, r32 = lane & 31, hi = lane >> 5;
    const int NT = (P0 + QB) / KVBLK;
    const int qlo = P0 + wid * QBLK, qm = qlo + r32 - 4 * hi;
    char* V_lds = lds; char* K_lds = lds + 2 * SHM_V;
    float* wsf = (float*)(lds + 2 * SHM_V + 2 * SHM_K) + wid * 64; float* li_l = wsf, * al_l = wsf + 32;
    float m_reg = -1e30f, l_reg = 0; f32x16 o[2] = {};
    const int sr = tid >> 4, sci = tid & 15; const bool kact = sci < 12;
    const int kws = KSWZ(sr, sci * 16);
    const int vr = tid >> 3, vc = (tid & 7) * 8, vst = v_st(vr, vc);
    const int vb0 = (int)(uintptr_t)V_lds + v_rd_base(lane);
    bf16x8 st_k0, st_k1, st_v;
    st_k0 = bf16x8{}; st_k1 = bf16x8{};
#define SLOAD(k0) do { if (kact) { st_k0 = *(const bf16x8*)(Kp + (size_t)((k0) + sr) * KLD + sci * 8); st_k1 = *(const bf16x8*)(Kp + (size_t)((k0) + 32 + sr) * KLD + sci * 8); } \
                       st_v = *(const bf16x8*)(Vp + (size_t)((k0) + vr) * VLD + vc); } while (0)
#define SWRITE_K(bf) do { if (kact) { *(bf16x8*)(K_lds + (bf) * SHM_K + kws) = st_k0; *(bf16x8*)(K_lds + (bf) * SHM_K + kws + 32 * 256) = st_k1; } } while (0)
#define SWRITE_V(bf) do { *(bf16x8*)(V_lds + (bf) * SHM_V + vst) = st_v; } while (0)
#define VMW() asm volatile("s_waitcnt vmcnt(0)" ::: "memory")
#define RESC(a) do { if (__any((a) < 1.f)) { if (hi == 0) al_l[r32] = (a); asm volatile("s_waitcnt lgkmcnt(0)" ::: "memory");              \
                     _Pragma("unroll") for (int d_ = 0; d_ < 2; ++d_) _Pragma("unroll") for (int r = 0; r < 16; ++r) o[d_][r] *= al_l[crow(r, hi)]; } } while (0)
#define KBASE(t) ((t) * KVBLK)
#define MASKT(P0_, P1_, t) do { const int kb_ = KBASE(t); if (kb_ + KVBLK - 1 > qlo) mask_tile(P0_, P1_, qm - kb_); } while (0)
    bf16x8 qr[6];
#pragma unroll
    for (int d0 = 0; d0 < 6; ++d0) qr[d0] = *(const bf16x8*)(Qp + (size_t)(wid * QBLK + r32) * QLD + d0 * 16 + hi * 8);
    SLOAD(0); VMW(); SWRITE_K(0); SWRITE_V(0); SBAR();
    SLOAD(KBASE(1));
    __syncthreads();
    f32x16 pA0, pA1, pB0, pB1; float alA, alB; bf16x8 pa0, pa1, pa2, pa3;
    SBAR(); qkt<0>(pA0, pA1, K_lds, r32, hi, qr);
    MASKT(pA0, pA1, 0); partialSM(pA0, pA1, m_reg, alA);
    VMW(); SWRITE_K(1); SWRITE_V(1);
    __syncthreads();
#define HALF_STEP(PX0, PX1, alX, PY0, PY1, alY, t, KB, VB, SB) do {                                                      \
        SBAR(); qkt<KB>(PX0, PX1, K_lds, r32, hi, qr);                                                                  \
        finishSM(PY0, PY1, alY, l_reg, pa0, pa1, pa2, pa3); SBAR();                                                     \
        if ((t) + 1 < NT) { SLOAD(KBASE((t) + 1)); SBAR(); }                                                            \
        pv_tile<VB>(o, vb0, pa0, pa1, pa2, pa3); MASKT(PX0, PX1, (t)); partialSM(PX0, PX1, m_reg, alX);                 \
        __syncthreads();                                                                                                \
        if ((t) + 1 < NT) { VMW(); SWRITE_K(SB); SWRITE_V(SB); }                                                        \
        RESC(alX); __syncthreads(); } while (0)
    for (int t = 1; t + 1 < NT; t += 2) {
        HALF_STEP(pB0, pB1, alB, pA0, pA1, alA, t, 1, 0, 0);
        HALF_STEP(pA0, pA1, alA, pB0, pB1, alB, t + 1, 0, 1, 1);
    }
    SBAR(); qkt<1>(pB0, pB1, K_lds, r32, hi, qr); SBAR();
    finishSM(pA0, pA1, alA, l_reg, pa0, pa1, pa2, pa3); SBAR();
    pv_tile<0>(o, vb0, pa0, pa1, pa2, pa3);
    MASKT(pB0, pB1, NT - 1); partialSM(pB0, pB1, m_reg, alB); RESC(alB);
    finishSM(pB0, pB1, alB, l_reg, pa0, pa1, pa2, pa3); SBAR(); pv_tile<1>(o, vb0, pa0, pa1, pa2, pa3);
    if (hi == 0) li_l[r32] = l_reg; asm volatile("s_waitcnt lgkmcnt(0)" ::: "memory");
    float rli[16];
#pragma unroll
    for (int r = 0; r < 16; ++r) rli[r] = __builtin_amdgcn_rcpf(li_l[crow(r, hi)]);
    bf16* Ow = Op + (size_t)(wid * QBLK) * OLD;
#pragma unroll
    for (int r = 0; r < 16; ++r) { const int orow = crow(r, hi);
#pragma unroll
        for (int d0 = 0; d0 < 2; ++d0) { const float v = o[d0][r] * rli[r];
            const float vn = __shfl_xor(v, 1);
            if ((r32 & 1) == 0) *(unsigned*)(Ow + (size_t)orow * OLD + d0 * 32 + r32) = cvtpk(v, vn); } }
    __syncthreads();
#undef SLOAD
#undef SWRITE_K
#undef SWRITE_V
#undef VMW
#undef RESC
#undef KBASE
#undef MASKT
#undef HALF_STEP
}
#undef KSWZ
#undef SBAR
}

__device__ __forceinline__ void p3_attention(Frame& F) {
    const bf16* Q = (const bf16*)(F.ws + WS_Q); const bf16* K = (const bf16*)(F.ws + WS_K); const bf16* V = (const bf16*)(F.ws + WS_V); bf16* O = (bf16*)(F.ws + WS_MIX);
    for (int item = F.vcu; item < NBATCH * NH * 16; item += F.G) {
        const int bh = item >> 4, x = item & 15, b = bh >> 3, h = bh & 7;
        const size_t rowbase = (size_t)b * SEQ;
#pragma unroll 1
        for (int pass = 0; pass < 2; ++pass) {
            const int qb = pass ? 31 - x : x;
            att::attn_block(Q + (rowbase + (size_t)qb * 256) * QLD + h * DQK, K + rowbase * KLD + h * DQK, V + rowbase * VLD + h * DV,
                            O + (rowbase + (size_t)qb * 256) * DM + h * DV, DM, qb * 256, (char*)F.lds);
        }
    }
}

__device__ __forceinline__ float gelu_f(float x) {
    const float t = 1.5957691216057308f * (x + 0.044715f * x * x * x);
    return x * __builtin_amdgcn_rcpf(1.f + __builtin_amdgcn_exp2f(-1.4426950408889634f * t));
}
constexpr int SG_VT_STRIDE = 136;
constexpr int SG_WAVE_BYTES = 64 * SG_VT_STRIDE * 2;
constexpr int SG_XCH_OFF = NWAVES * SG_WAVE_BYTES;
static_assert(SG_XCH_OFF + 2 * 128 * 8 * 4 <= LDSCTL_OFF, "SG LDS");
__device__ __forceinline__ void p4_sg(Frame& F, const Args& A) {
    int lane_ = F.lane; asm volatile("" : "+v"(lane_));
    const int lane = lane_, h = F.wave, r32 = lane & 31, hi = lane >> 5;
    int vz = 0; asm volatile("" : "+v"(vz));
    const bf16* z = (const bf16*)(F.ws + WS_Z); bf16* mix = (bf16*)(F.ws + WS_MIX); float* rstd1 = (float*)(F.ws + WS_RSTD1);
    const float* sg_norm_g = A.in[9]; const float* w_sp = A.in[10]; const float* b_sp = A.in[11]; const float* sg_out_g = A.in[13];
    LAS unsigned char* my = F.lds + h * SG_WAVE_BYTES;
    LAS float* xsg = (LAS float*)(F.lds + SG_XCH_OFF); LAS float* xml = xsg + 128 * 8;
    for (int unit = F.vcu; unit < NBATCH * (SEQ / SGC); unit += F.G) {
        const size_t row0 = (size_t)unit * SGC;
#pragma unroll 1
        for (int half = 0; half < 2; ++half) {
            const int s = lane + 64 * half;
            asm volatile("" : "+v"(vz));
            const bf16* vp = z + (row0 + s) * ZLD + ZC_V + h * SGD;
            float v[64]; float ss = 0.f;
#pragma unroll
            for (int ch = 0; ch < 8; ++ch) { const v4u w = *(const v4u*)(vp + ch * 8);
#pragma unroll
                for (int q = 0; q < 4; ++q) { const float a = gelu_f(bflo(w[q])), b = gelu_f(bfhi(w[q])); v[ch * 8 + 2 * q] = a; v[ch * 8 + 2 * q + 1] = b; ss += a * a + b * b; } }
            const float rs = rsqrtf(ss * (1.f / 64.f) + EPS);
#pragma unroll
            for (int c = 0; c < 64; ++c) *(LAS unsigned short*)(my + (c * SG_VT_STRIDE + s) * 2) = (unsigned short)f2bf(v[c] * rs * sg_norm_g[h * SGD + c + vz]);
        }
        LDS_WAIT(); asm volatile("" ::: "memory");
#pragma unroll 1
        for (int cb = 0; cb < 2; ++cb) {
            f32x16 acc[4];
#pragma unroll
            for (int tb = 0; tb < 4; ++tb) {
                acc[tb] = f32x16{};
                int t = 32 * tb + r32; asm volatile("" : "+v"(t));
                const float* wrow = w_sp + ((size_t)h * SGC + t) * SGC;
#pragma unroll
                for (int ks = 0; ks < 8; ++ks) {
                    if (ks <= 2 * tb + 1) {
                        const int s0 = 16 * ks + 8 * hi;
                        const f32x4 w0 = *(const f32x4*)(wrow + s0), w1 = *(const f32x4*)(wrow + s0 + 4);
                        float wv[8] = {w0[0], w0[1], w0[2], w0[3], w1[0], w1[1], w1[2], w1[3]};
                        if (ks >= 2 * tb) {
#pragma unroll
                            for (int j = 0; j < 8; ++j) wv[j] = (s0 + j > t) ? 0.f : wv[j];
                        }
                        v4u aw; aw.x = pk2(wv[0], wv[1]); aw.y = pk2(wv[2], wv[3]); aw.z = pk2(wv[4], wv[5]); aw.w = pk2(wv[6], wv[7]);
                        const bf16x8 a = __builtin_bit_cast(bf16x8, aw);
                        const bf16x8 b0 = *(const LAS bf16x8*)(my + ((32 * cb + r32) * SG_VT_STRIDE + s0) * 2);
                        acc[tb] = __builtin_amdgcn_mfma_f32_32x32x16_bf16(a, b0, acc[tb], 0, 0, 0);
                    }
                    if (ks & 1) asm volatile("" ::: "memory");
                }
            }
            LDS_WAIT(); asm volatile("" ::: "memory");
#pragma unroll
            for (int tb = 0; tb < 4; ++tb)
#pragma unroll
                for (int r = 0; r < 16; ++r) {
                    const int t = 32 * tb + (r & 3) + 8 * (r >> 2) + 4 * hi;
                    *(LAS unsigned short*)(my + cb * 8704 + t * 64 + (((r32 >> 3) ^ ((t >> 2) & 3)) << 4) + (r32 & 7) * 2) = (unsigned short)f2bf(acc[tb][r]);
                }
            LDS_WAIT(); asm volatile("" ::: "memory");
        }
#pragma unroll 1
        for (int half = 0; half < 2; ++half) {
            const int t = lane + 64 * half;
            const bf16* up = z + (row0 + t) * ZLD + ZC_U + h * SGD;
            const bf16* mp = mix + (row0 + t) * DM + h * DV;
            const float bias = b_sp[h * SGC + t];
            float ss = 0.f, sm = 0.f;
#pragma unroll
            for (int ch = 0; ch < 8; ++ch) {
                LAS v4u* vmp = (LAS v4u*)(my + (ch >> 2) * 8704 + t * 64 + (((ch & 3) ^ ((t >> 2) & 3)) << 4));
                const v4u vw = *vmp; const v4u uw = *(const v4u*)(up + ch * 8); const v4u mw = *(const v4u*)(mp + ch * 8);
                v4u ow;
#pragma unroll
                for (int q = 0; q < 4; ++q) {
                    const float o0 = gelu_f(bflo(uw[q])) * (bflo(vw[q]) + bias), o1 = gelu_f(bfhi(uw[q])) * (bfhi(vw[q]) + bias);
                    ss += o0 * o0 + o1 * o1; ow[q] = pk2(o0, o1);
                    const float m0 = bflo(mw[q]), m1 = bfhi(mw[q]); sm += m0 * m0 + m1 * m1;
                }
                *vmp = ow;
            }
            xsg[t * 8 + h] = ss; xml[t * 8 + h] = sm;
        }
        LDS_WAIT(); __syncthreads();
#pragma unroll 1
        for (int half = 0; half < 2; ++half) {
            const int t = lane + 64 * half;
            asm volatile("" : "+v"(vz));
            float t2 = 0.f, t1 = 0.f;
#pragma unroll
            for (int k = 0; k < 8; ++k) { t2 += xsg[t * 8 + k]; t1 += xml[t * 8 + k]; }
            const float r1 = rsqrtf(t1 * (1.f / 512.f) + EPS);
            const float f = rsqrtf(t2 * (1.f / 512.f) + EPS) / r1;
            if (h == 0) rstd1[row0 + t] = r1;
            bf16* op = mix + (row0 + t) * DM + 512 + h * SGD;
#pragma unroll
            for (int ch = 0; ch < 8; ++ch) {
                const v4u ow = *(LAS v4u*)(my + (ch >> 2) * 8704 + t * 64 + (((ch & 3) ^ ((t >> 2) & 3)) << 4));
                const f32x4 g0 = *(const f32x4*)(sg_out_g + h * SGD + ch * 8 + vz), g1 = *(const f32x4*)(sg_out_g + h * SGD + ch * 8 + 4 + vz);
                v4u w;
                w.x = pk2(bflo(ow.x) * f * g0[0], bfhi(ow.x) * f * g0[1]); w.y = pk2(bflo(ow.y) * f * g0[2], bfhi(ow.y) * f * g0[3]);
                w.z = pk2(bflo(ow.z) * f * g1[0], bfhi(ow.z) * f * g1[1]); w.w = pk2(bflo(ow.w) * f * g1[2], bfhi(ow.w) * f * g1[3]);
                *(v4u*)(op + ch * 8) = w;
            }
        }
        LDS_WAIT(); __syncthreads();
    }
}

namespace pg8 {
struct EpiT {
    static constexpr bool PERM = true, AFTER_DRAIN = false;
    bf16_t* T; const float* rstd1; float* tpart;
    __device__ __forceinline__ void operator()(const f32x4 (&acc)[2][2][4][2], const Unit& u, int wr, int wc, int fr, int fq) const {
        const int row0 = u.pm * BM + wr * 64 + fr, col0 = u.pn * BM + wc * 32 + 8 * fq;
#pragma unroll
        for (int ai = 0; ai < 2; ++ai)
#pragma unroll
            for (int m = 0; m < 4; ++m) {
                const int row = row0 + ai * HALF + m * 16; const float rs = rstd1[row]; float s = 0.f;
#pragma unroll
                for (int bj = 0; bj < 2; ++bj) {
                    const f32x4 v0 = acc[ai][bj][m][0] * rs, v1 = acc[ai][bj][m][1] * rs;
                    u32x4 w; w.x = cvt_pk_bf16(v0[0], v0[1]); w.y = cvt_pk_bf16(v0[2], v0[3]); w.z = cvt_pk_bf16(v1[0], v1[1]); w.w = cvt_pk_bf16(v1[2], v1[3]);
                    *(u32x4*)(T + (size_t)row * 1024 + col0 + bj * HALF) = w;
                    s += (v0[0] * v0[0] + v0[1] * v0[1]) + (v0[2] * v0[2] + v0[3] * v0[3]) + (v1[0] * v1[0] + v1[1] * v1[1]) + (v1[2] * v1[2] + v1[3] * v1[3]);
                }
                s += __shfl_xor(s, 16); s += __shfl_xor(s, 32);
                if (fq == 0) tpart[row * 16 + u.pn * 4 + wc] = s;
            }
    }
};
}

constexpr int P6_LG_OFF = 0;
__device__ __forceinline__ void p6_rowpass(Frame& F, const Args& A) {
    int lane_ = F.lane; asm volatile("" : "+v"(lane_));
    const int lane = lane_, r = lane & 15, kg = lane >> 4;
    const bf16* tb = (const bf16*)(F.ws + WS_TB); const float* tpart = (const float*)(F.ws + WS_TPART);
    const float* x = A.in[0]; const float* gpost = A.in[15]; const bf16* wr = (const bf16*)(F.ws + WS_WR); const float* brt = A.in[18];
    float* x1 = F.out; unsigned char* x1q = F.ws + WS_X1Q; float* rstdx1 = (float*)(F.ws + WS_RSTDX1);
    int* topi = (int*)(F.ws + WS_TOPI); float* topw = (float*)(F.ws + WS_TOPW);
    LAS float* lg = (LAS float*)(F.lds + P6_LG_OFF) + F.wave * (16 * 33);
    LAS int* hist = (LAS int*)(F.lds + 17408);
    int* rbhist = (int*)(F.ws + WS_RBHIST);
    for (int rb = F.vcu; rb < M / 64; rb += F.G) {
      if (F.tid < 32) hist[F.tid] = 0;
      LDS_WAIT(); __syncthreads();
      if (F.wave < 4) {
        const int blk = rb * 4 + F.wave;
        const size_t row = (size_t)blk * 16 + r;
        float ts = 0.f;
        { const f32x4* tp = (const f32x4*)(tpart + row * 16);
#pragma unroll
          for (int q = 0; q < 4; ++q) { const f32x4 v = tp[q]; ts += (v[0] + v[1]) + (v[2] + v[3]); } }
        const float rst = rsqrtf(ts * (1.f / 1024.f) + EPS);
        f32x4 acc0 = {0.f, 0.f, 0.f, 0.f}, acc1 = {0.f, 0.f, 0.f, 0.f};
        float ss = 0.f;
#pragma unroll 4
        for (int s = 0; s < 32; ++s) {
            const int k = 32 * s + 8 * kg;
            const v4u tw = *(const v4u*)(tb + row * DM + k);
            const f32x4 xa = *(const f32x4*)(x + row * DM + k), xb_ = *(const f32x4*)(x + row * DM + k + 4);
            const f32x4 ga = *(const f32x4*)(gpost + k), gb = *(const f32x4*)(gpost + k + 4);
            f32x4 ya, yb;
            ya[0] = xa[0] + bflo(tw.x) * rst * ga[0]; ya[1] = xa[1] + bfhi(tw.x) * rst * ga[1]; ya[2] = xa[2] + bflo(tw.y) * rst * ga[2]; ya[3] = xa[3] + bfhi(tw.y) * rst * ga[3];
            yb[0] = xb_[0] + bflo(tw.z) * rst * gb[0]; yb[1] = xb_[1] + bfhi(tw.z) * rst * gb[1]; yb[2] = xb_[2] + bflo(tw.w) * rst * gb[2]; yb[3] = xb_[3] + bfhi(tw.w) * rst * gb[3];
            *(f32x4*)(x1 + row * DM + k) = ya; *(f32x4*)(x1 + row * DM + k + 4) = yb;
            v4u aw; aw.x = pk2(ya[0], ya[1]); aw.y = pk2(ya[2], ya[3]); aw.z = pk2(yb[0], yb[1]); aw.w = pk2(yb[2], yb[3]);
            { v2u qw; qw.x = pk4_fp8(ya[0], ya[1], ya[2], ya[3]); qw.y = pk4_fp8(yb[0], yb[1], yb[2], yb[3]); *(v2u*)(x1q + row * DM + k) = qw; }
            ss += (ya[0] * ya[0] + ya[1] * ya[1]) + (ya[2] * ya[2] + ya[3] * ya[3]) + (yb[0] * yb[0] + yb[1] * yb[1]) + (yb[2] * yb[2] + yb[3] * yb[3]);
            const bf16x8 a = __builtin_bit_cast(bf16x8, aw);
            const bf16x8 b0 = *(const bf16x8*)(wr + (size_t)r * DM + k), b1 = *(const bf16x8*)(wr + (size_t)(16 + r) * DM + k);
            acc0 = __builtin_amdgcn_mfma_f32_16x16x32_bf16(a, b0, acc0, 0, 0, 0);
            acc1 = __builtin_amdgcn_mfma_f32_16x16x32_bf16(a, b1, acc1, 0, 0, 0);
        }
        ss += __shfl_xor(ss, 16); ss += __shfl_xor(ss, 32);
        const float rs1 = rsqrtf(ss * (1.f / 1024.f) + EPS);
        if (kg == 0) rstdx1[row] = rs1;
#pragma unroll
        for (int i = 0; i < 4; ++i) { lg[(4 * kg + i) * 33 + r] = acc0[i]; lg[(4 * kg + i) * 33 + 16 + r] = acc1[i]; }
        LDS_WAIT(); asm volatile("" ::: "memory");
        if (kg == 0) {
            float v[32];
#pragma unroll
            for (int e = 0; e < 32; ++e) v[e] = lg[r * 33 + e] * rs1 + brt[e];
            int idx[4]; float val[4];
#pragma unroll
            for (int k = 0; k < 4; ++k) {
                int bi = 0; float bv = -3.0e38f;
#pragma unroll
                for (int e = 0; e < 32; ++e) if (v[e] > bv) { bv = v[e]; bi = e; }
                idx[k] = bi; val[k] = bv;
#pragma unroll
                for (int e = 0; e < 32; ++e) if (e == bi) v[e] = -3.0e38f;
            }
            float ex[4], sum = 0.f;
#pragma unroll
            for (int k = 0; k < 4; ++k) { ex[k] = __expf(val[k] - val[0]); sum += ex[k]; }
            const float inv = 1.f / sum;
            *(int4*)(topi + row * 4) = make_int4(idx[0], idx[1], idx[2], idx[3]);
            *(f32x4*)(topw + row * 4) = (f32x4){ex[0] * inv, ex[1] * inv, ex[2] * inv, ex[3] * inv};
#pragma unroll
            for (int k = 0; k < 4; ++k) (void)__hip_atomic_fetch_add(hist + idx[k], 1, __ATOMIC_RELAXED, __HIP_MEMORY_SCOPE_WORKGROUP);
        }
      }
      LDS_WAIT(); __syncthreads();
      if (F.tid < 32) rbhist[rb * 32 + F.tid] = hist[F.tid];
    }
}

constexpr int NRB = M / 64;
constexpr int P7_LDS_E = 0, P7_LDS_BASE = 1024, P7_LDS_RED = 2048, P7_LDS_DEST = 8192;
__device__ __forceinline__ void p7_route(Frame& F) {
    int tid_ = F.tid; asm volatile("" : "+v"(tid_));
    const int tid = tid_;
    unsigned char* ws = F.ws;
    const int* topi = (const int*)(ws + WS_TOPI); const float* topw = (const float*)(ws + WS_TOPW); const float* rstdx1 = (const float*)(ws + WS_RSTDX1);
    const int* rbhist = (const int*)(ws + WS_RBHIST); int* rowslot = (int*)(ws + WS_ROWSLOT); float* roww = (float*)(ws + WS_ROWW); float* rss = (float*)(ws + WS_RSS);
    int* texp = (int*)(ws + WS_TEXP);
    const unsigned char* x1q = ws + WS_X1Q; unsigned char* Xs = ws + WS_XS;
    LAS int* eid = (LAS int*)(F.lds + P7_LDS_E); LAS int* base = (LAS int*)(F.lds + P7_LDS_BASE); LAS int* tot = base + 32; LAS int* off = base + 64;
    LAS int* red = (LAS int*)(F.lds + P7_LDS_RED); LAS int* dst = (LAS int*)(F.lds + P7_LDS_DEST);
    for (int rb = F.vcu; rb < NRB; rb += F.G) {
        { const int e = tid & 31, part = tid >> 5; int sb = 0, st = 0;
#pragma unroll 4
          for (int i = 0; i < 16; ++i) { const int r2 = part * 16 + i; const int c = rbhist[r2 * 32 + e]; st += c; if (r2 < rb) sb += c; }
          red[part * 32 + e] = sb; red[512 + part * 32 + e] = st; }
        if (tid < 256) eid[tid] = topi[(size_t)rb * 256 + tid];
        LDS_WAIT(); __syncthreads();
        if (tid < 32) { int sb = 0, st = 0;
#pragma unroll
            for (int p = 0; p < 16; ++p) { sb += red[p * 32 + tid]; st += red[512 + p * 32 + tid]; }
            base[tid] = sb; tot[tid] = st; }
        LDS_WAIT(); __syncthreads();
        if (tid == 0) { int o = 0;
            for (int e = 0; e < 32; ++e) { off[e] = o; o += (tot[e] + 255) & ~255; }
            if (rb == 0) { F.ctl[CW_NTILES] = (unsigned)(o >> 8);
                for (int e = 0; e < 32; ++e) { const int t0 = off[e] >> 8, nt = (tot[e] + 255) >> 8; for (int t = 0; t < nt; ++t) texp[t0 + t] = e; } } }
        LDS_WAIT(); __syncthreads();
        if (tid < 256) {
            const int e = eid[tid]; int rank = 0;
            for (int j = 0; j < tid; ++j) rank += (eid[j] == e) ? 1 : 0;
            const int d = off[e] + base[e] + rank; dst[tid] = d;
            const int row = rb * 64 + (tid >> 2);
            rowslot[d] = row * 4 + (tid & 3); roww[d] = topw[(size_t)rb * 256 + tid]; rss[d] = rstdx1[row];
        }
        if (rb < 32) {
            const int e = rb, c = tot[e], pe = (c + 255) & ~255;
            if (tid < pe - c) { rowslot[off[e] + c + tid] = -1; roww[off[e] + c + tid] = 0.f; rss[off[e] + c + tid] = 0.f; }
        }
        LDS_WAIT(); __syncthreads();
        for (int i = tid; i < 256 * 64; i += NWAVES * 64) {
            const int ent = i >> 6, ch = i & 63; const int row = rb * 64 + (ent >> 2);
            const v4u v = *(const v4u*)(x1q + (size_t)row * DM + ch * 16);
            *(v4u*)(Xs + (size_t)dst[ent] * DM + ch * 16) = v;
        }
        LDS_WAIT(); __syncthreads();
    }
}

namespace pg8 {
struct MoeOrder {
    StaticOrder so; const int* texp; int nn;
    __device__ void init(int ntiles, int nn_, int G_, int c_, const int* texp_) { so.init(ntiles * BM, nn_ * BM, G_, c_); texp = texp_; nn = nn_; }
    __device__ bool next(int i, Unit& u) const { if (!so.next(i, u)) return false; const int e = texp[u.pm]; u.pn += e * nn; return true; }
    __device__ __forceinline__ void a_ready(const Unit&) const {}
    __device__ __forceinline__ void done(const Unit&) const {}
};
struct EpiGU {
    static constexpr bool PERM = true, AFTER_DRAIN = false;
    unsigned char* Hs; const float* rss; const float* bgu;
    __device__ __forceinline__ void operator()(const f32x4 (&acc)[2][2][4][2], const Unit& u, int wr, int wc, int fr, int fq) const {
        const int e = u.pn >> 3, pnl = u.pn & 7;
        const int row0 = u.pm * BM + wr * 64 + fr, jb = 128 * pnl + 32 * wc + 8 * fq;
        const f32x4 bg0 = *(const f32x4*)(bgu + e * 2048 + jb), bg1 = *(const f32x4*)(bgu + e * 2048 + jb + 4);
        const f32x4 bu0 = *(const f32x4*)(bgu + e * 2048 + 1024 + jb), bu1 = *(const f32x4*)(bgu + e * 2048 + 1024 + jb + 4);
#pragma unroll
        for (int ai = 0; ai < 2; ++ai)
#pragma unroll
            for (int m = 0; m < 4; ++m) {
                const int row = row0 + ai * HALF + m * 16; const float rs = rss[row];
                float a[8];
#pragma unroll
                for (int n = 0; n < 2; ++n)
#pragma unroll
                    for (int i = 0; i < 4; ++i) {
                        float g = acc[ai][0][m][n][i] * rs + (n ? bg1[i] : bg0[i]), uu = acc[ai][1][m][n][i] * rs + (n ? bu1[i] : bu0[i]);
                        g = fminf(g, 7.f); uu = fminf(fmaxf(uu, -7.f), 7.f);
                        a[4 * n + i] = (uu + 1.f) * g * __builtin_amdgcn_rcpf(1.f + __builtin_amdgcn_exp2f(-1.702f * 1.4426950408889634f * g));
                    }
                v2u w; w.x = pk4_fp8(a[0], a[1], a[2], a[3]); w.y = pk4_fp8(a[4], a[5], a[6], a[7]);
                *(v2u*)(Hs + (size_t)row * 1024 + jb) = w;
            }
    }
};
struct EpiDown {
    static constexpr bool PERM = true, AFTER_DRAIN = false;
    bf16_t* Y; const int* rowslot; const float* roww; const float* bd;
    __device__ __forceinline__ void operator()(const f32x4 (&acc)[2][2][4][2], const Unit& u, int wr, int wc, int fr, int fq) const {
        const int e = u.pn >> 2, pnl = u.pn & 3;
        const int row0 = u.pm * BM + wr * 64 + fr, col0 = pnl * BM + wc * 32 + 8 * fq;
        f32x4 b0[2], b1[2];
#pragma unroll
        for (int bj = 0; bj < 2; ++bj) { b0[bj] = *(const f32x4*)(bd + e * 1024 + col0 + bj * HALF); b1[bj] = *(const f32x4*)(bd + e * 1024 + col0 + bj * HALF + 4); }
#pragma unroll
        for (int ai = 0; ai < 2; ++ai)
#pragma unroll
            for (int m = 0; m < 4; ++m) {
                const int row = row0 + ai * HALF + m * 16; const int slot = rowslot[row]; const float gw = roww[row];
                if (slot >= 0) {
#pragma unroll
                    for (int bj = 0; bj < 2; ++bj) {
                        const f32x4 v0 = (acc[ai][bj][m][0] + b0[bj]) * gw, v1 = (acc[ai][bj][m][1] + b1[bj]) * gw;
                        u32x4 w; w.x = cvt_pk_bf16(v0[0], v0[1]); w.y = cvt_pk_bf16(v0[2], v0[3]); w.z = cvt_pk_bf16(v1[0], v1[1]); w.w = cvt_pk_bf16(v1[2], v1[3]);
                        *(u32x4*)(Y + (size_t)slot * 1024 + col0 + bj * HALF) = w;
                    }
                }
            }
    }
};
struct EpiPle {
    static constexpr bool PERM = true, AFTER_DRAIN = false;
    bf16_t* V; const bf16_t* PP; const float* bias; float* vpart;
    __device__ __forceinline__ void operator()(const f32x4 (&acc)[2][2][4][2], const Unit& u, int wr, int wc, int fr, int fq) const {
        const int row0 = u.pm * BM + wr * 64 + fr, col0 = u.pn * BM + wc * 32 + 8 * fq;
        f32x4 b0[2], b1[2];
#pragma unroll
        for (int bj = 0; bj < 2; ++bj) { b0[bj] = *(const f32x4*)(bias + col0 + bj * HALF); b1[bj] = *(const f32x4*)(bias + col0 + bj * HALF + 4); }
#pragma unroll
        for (int ai = 0; ai < 2; ++ai)
#pragma unroll
            for (int m = 0; m < 4; ++m) {
                const int row = row0 + ai * HALF + m * 16; float s = 0.f;
#pragma unroll
                for (int bj = 0; bj < 2; ++bj) {
                    const u32x4 pw = *(const u32x4*)(PP + (size_t)row * 1024 + col0 + bj * HALF);
                    const f32x4 l0 = acc[ai][bj][m][0] + b0[bj], l1 = acc[ai][bj][m][1] + b1[bj];
                    float v[8];
#pragma unroll
                    for (int i = 0; i < 4; ++i) {
                        v[i] = __builtin_amdgcn_rcpf(1.f + __builtin_amdgcn_exp2f(-1.4426950408889634f * l0[i]));
                        v[4 + i] = __builtin_amdgcn_rcpf(1.f + __builtin_amdgcn_exp2f(-1.4426950408889634f * l1[i]));
                    }
                    v[0] *= __builtin_bit_cast(float, pw.x << 16); v[1] *= __builtin_bit_cast(float, pw.x & 0xffff0000u);
                    v[2] *= __builtin_bit_cast(float, pw.y << 16); v[3] *= __builtin_bit_cast(float, pw.y & 0xffff0000u);
                    v[4] *= __builtin_bit_cast(float, pw.z << 16); v[5] *= __builtin_bit_cast(float, pw.z & 0xffff0000u);
                    v[6] *= __builtin_bit_cast(float, pw.w << 16); v[7] *= __builtin_bit_cast(float, pw.w & 0xffff0000u);
                    u32x4 w; w.x = cvt_pk_bf16(v[0], v[1]); w.y = cvt_pk_bf16(v[2], v[3]); w.z = cvt_pk_bf16(v[4], v[5]); w.w = cvt_pk_bf16(v[6], v[7]);
                    *(u32x4*)(V + (size_t)row * 1024 + col0 + bj * HALF) = w;
                    s += (v[0] * v[0] + v[1] * v[1]) + (v[2] * v[2] + v[3] * v[3]) + (v[4] * v[4] + v[5] * v[5]) + (v[6] * v[6] + v[7] * v[7]);
                }
                s += __shfl_xor(s, 16); s += __shfl_xor(s, 32);
                if (fq == 0) vpart[row * 16 + u.pn * 4 + wc] = s;
                asm volatile("" ::: "memory");
            }
    }
};
}

__device__ __forceinline__ void p10_rowpass(Frame& F, const Args& A) {
    int lane_ = F.lane; asm volatile("" : "+v"(lane_));
    const int lane = lane_;
    const bf16* ys = (const bf16*)(F.ws + WS_YS); bf16* x2b = (bf16*)(F.ws + WS_X2B); float* xo = F.out; const float* g = A.in[23];
    const int gw = F.vcu * NWAVES + F.wave, NGW = F.G * NWAVES;
    for (int row = gw; row < M; row += NGW) {
        f32x4 y[4]; float ss = 0.f;
#pragma unroll
        for (int j = 0; j < 4; ++j) {
            y[j] = (f32x4){0.f, 0.f, 0.f, 0.f};
#pragma unroll
            for (int k = 0; k < 4; ++k) { const v2u w = *((const v2u*)(ys + ((size_t)row * 4 + k) * DM) + lane + 64 * j);
                y[j][0] += bflo(w.x); y[j][1] += bfhi(w.x); y[j][2] += bflo(w.y); y[j][3] += bfhi(w.y); }
            ss += (y[j][0] * y[j][0] + y[j][1] * y[j][1]) + (y[j][2] * y[j][2] + y[j][3] * y[j][3]);
        }
        const float rs = rsqrtf(wave_sum(ss) * (1.f / DM) + EPS);
#pragma unroll
        for (int j = 0; j < 4; ++j) {
            f32x4* xp = (f32x4*)(xo + (size_t)row * DM) + lane + 64 * j;
            const f32x4 gg = *((const f32x4*)g + lane + 64 * j);
            const f32x4 x2 = *xp + y[j] * rs * gg;
            *xp = x2;
            v2u w; w.x = pk2(x2[0], x2[1]); w.y = pk2(x2[2], x2[3]);
            *((v2u*)(x2b + (size_t)row * DM) + lane + 64 * j) = w;
        }
    }
}
__device__ __forceinline__ void p12_final(Frame& F, const Args& A) {
    int lane_ = F.lane; asm volatile("" : "+v"(lane_));
    const int lane = lane_;
    const bf16* vb = (const bf16*)(F.ws + WS_VB); const float* vpart = (const float*)(F.ws + WS_VPART); float* xo = F.out; const float* g = A.in[27];
    const int gw = F.vcu * NWAVES + F.wave, NGW = F.G * NWAVES;
    for (int row = gw; row < M; row += NGW) {
        float s = (lane < 16) ? vpart[(size_t)row * 16 + lane] : 0.f;
        s = wave_sum(s);
        const float rs = rsqrtf(s * (1.f / DM) + EPS);
#pragma unroll
        for (int j = 0; j < 4; ++j) {
            f32x4* xp = (f32x4*)(xo + (size_t)row * DM) + lane + 64 * j;
            const f32x4 gg = *((const f32x4*)g + lane + 64 * j);
            const v2u w = *((const v2u*)(vb + (size_t)row * DM) + lane + 64 * j);
            f32x4 o = *xp;
            o[0] += bflo(w.x) * rs * gg[0]; o[1] += bfhi(w.x) * rs * gg[1]; o[2] += bflo(w.y) * rs * gg[2]; o[3] += bfhi(w.y) * rs * gg[3];
            *xp = o;
        }
    }
}

constexpr int NPHASE = 13;
template <unsigned PM> __global__ void __launch_bounds__(NWAVES * 64, 2) mk_fwd(Args args) {
    extern __shared__ __attribute__((aligned(16))) unsigned char lds[];
    Frame F;
    F.lds = (LAS unsigned char*)lds;
    F.MISC = (volatile LAS unsigned*)(F.lds + MISC_OFF);
    F.tid = threadIdx.x; F.lane = F.tid & 63; F.wave = __builtin_amdgcn_readfirstlane(F.tid >> 6);
    F.G = gridDim.x; { const int bx = blockIdx.x; F.vcu = (F.G % 8 == 0) ? (bx % 8) * (F.G / 8) + bx / 8 : bx; }
    F.ws = args.ws; F.ctl = (gu32*)(args.ws + WS_CTL); F.out = args.out;
    unsigned char* ws = args.ws;
    for (int u = F.tid; u < (LDS_BYTES - LDSCTL_OFF) / 4; u += NWAVES * 64) ((LAS unsigned*)(F.lds + LDSCTL_OFF))[u] = 0u;
    __syncthreads();
    const bool single = (args.ph_hi - args.ph_lo) > 1;
    XcdBarrier bar; bar.bar = (unsigned*)(F.ctl + CW_BAR); bar.x = 0; bar.st = nullptr;
    if (single) bar = xcd_barrier_post((unsigned*)(F.ctl + CW_BAR), F.MISC + 8);
    const int lo = args.ph_lo, hi = args.ph_hi;
#define IN(k) (((PM >> (k)) & 1) && lo <= (k) && (k) < hi)
#define SEAM(k) do { if (IN(k) && IN((k) + 1)) xcd_barrier(bar); } while (0)

    if (IN(0)) { p0_prologue<MOE_WEIGHTS>(F, args); } SEAM(0);

    if (IN(1)) {
        pg8::Gemm g{(const bf16*)(ws + WS_XB), (const bf16*)(ws + WS_WIN), M, ZLD, DM, DM, DM}; pg8::StaticOrder S; S.init(M, ZLD, F.G, (int)blockIdx.x);
        pg8::EpiZ E{(bf16*)(ws + WS_Z), (const float*)(ws + WS_RSTDX), (float*)(ws + WS_QPART), (float*)(ws + WS_KVPART)};
        pg8::gemm_phase<pg8::EpiZ, pg8::StaticOrder, true, true>(F.lds + RING_OFF, g, S, E);
    } SEAM(1);

    if (IN(2)) {
#ifndef P2SEL
#define P2SEL 15
#endif
        if (P2SEL & 1) p2_krope(F);
        if (P2SEL & 2) { pg8::Gemm g{(const bf16*)(ws + WS_Z), (const bf16*)(ws + WS_WUQ), M, QLD, Q_LORA, ZLD, Q_LORA}; pg8::StaticOrder S; S.init(M, QLD, F.G, (int)blockIdx.x);
          pg8::EpiQ E{(bf16*)(ws + WS_Q), (const float*)(ws + WS_QPART), (const f32x2*)(ws + WS_ROPE)};
          pg8::gemm_phase<pg8::EpiQ, pg8::StaticOrder, true, true>(F.lds + RING_OFF, g, S, E); }
        if (P2SEL & 4) { pg8::Gemm g{(const bf16*)(ws + WS_Z) + ZC_KV, (const bf16*)(ws + WS_WUKV), M, 1024, KV_LORA, ZLD, KV_LORA}; pg8::StaticOrder S; S.init(M, 1024, F.G, (int)blockIdx.x);
          pg8::EpiKV E{(bf16*)(ws + WS_K), (bf16*)(ws + WS_V), (const float*)(ws + WS_KVPART)};
          pg8::gemm_phase<pg8::EpiKV, pg8::StaticOrder, true, true>(F.lds + RING_OFF, g, S, E); }
        if (P2SEL & 8) { pg8::Gemm g{(const bf16*)(ws + WS_PB), (const bf16*)(ws + WS_WPP), M, DM, DPLE, DPLE, DPLE}; pg8::StaticOrder S; S.init(M, DM, F.G, (int)blockIdx.x);
          pg8::EpiStore E{(bf16*)(ws + WS_PPB), DM, nullptr};
          pg8::gemm_phase<pg8::EpiStore, pg8::StaticOrder, true, true>(F.lds + RING_OFF, g, S, E); }
    } SEAM(2);

    if (IN(3)) { p3_attention(F); } SEAM(3);

    if (IN(4)) { p4_sg(F, args); } SEAM(4);

    if (IN(5)) {
        pg8::Gemm g{(const bf16*)(ws + WS_MIX), (const bf16*)(ws + WS_WOUT), M, DM, DM, DM, DM}; pg8::StaticOrder S; S.init(M, DM, F.G, (int)blockIdx.x);
        pg8::EpiT E{(bf16*)(ws + WS_TB), (const float*)(ws + WS_RSTD1), (float*)(ws + WS_TPART)};
        pg8::gemm_phase<pg8::EpiT, pg8::StaticOrder, true, true>(F.lds + RING_OFF, g, S, E);
    } SEAM(5);

    if (IN(6)) { p6_rowpass(F, args); } SEAM(6);

    if (IN(7)) { p7_route(F); } SEAM(7);

    if (IN(8)) {
        const int ntiles = (int)F.ctl[CW_NTILES];
        pg8::Gemm g{(const bf16*)(ws + WS_XS), (const bf16*)(ws + WS_WGU), 0, 0, DM / 2, DM / 2, DM / 2};
        pg8::MoeOrder S; S.init(ntiles, 8, F.G, (int)blockIdx.x, (const int*)(ws + WS_TEXP));
        pg8::EpiGU E{ws + WS_HS, (const float*)(ws + WS_RSS), args.in[20]};
        pg8::gemm_phase<pg8::EpiGU, pg8::MoeOrder, true, true, true>(F.lds + RING_OFF, g, S, E);
    } SEAM(8);

    if (IN(9)) {
        const int ntiles = (int)F.ctl[CW_NTILES];
        pg8::Gemm g{(const bf16*)(ws + WS_HS), (const bf16*)(ws + WS_WD), 0, 0, DE / 2, DE / 2, DE / 2};
        pg8::MoeOrder S; S.init(ntiles, 4, F.G, (int)blockIdx.x, (const int*)(ws + WS_TEXP));
        pg8::EpiDown E{(bf16*)(ws + WS_YS), (const int*)(ws + WS_ROWSLOT), (const float*)(ws + WS_ROWW), args.in[22]};
        pg8::gemm_phase<pg8::EpiDown, pg8::MoeOrder, true, true, true>(F.lds + RING_OFF, g, S, E);
    } SEAM(9);

    if (IN(10)) { p10_rowpass(F, args); } SEAM(10);

    if (IN(11)) {
        pg8::Gemm g{(const bf16*)(ws + WS_X2B), (const bf16*)(ws + WS_WPG), M, DM, DM, DM, DM}; pg8::StaticOrder S; S.init(M, DM, F.G, (int)blockIdx.x);
        pg8::EpiPle E{(bf16*)(ws + WS_VB), (const bf16*)(ws + WS_PPB), args.in[25], (float*)(ws + WS_VPART)};
        pg8::gemm_phase<pg8::EpiPle, pg8::StaticOrder, true, true>(F.lds + RING_OFF, g, S, E);
    } SEAM(11);

    if (IN(12)) { p12_final(F, args); }
#undef IN
#undef SEAM
}

extern "C" void kernel_launch(void* const* d_in, const int* in_sizes, int n_in, void* d_out, int out_size, void* d_ws, size_t ws_size,
                              hipStream_t stream) {
    static int grid = 0;
    if (grid == 0) {
        int dev = 0, cus = 0;
        if (hipGetDevice(&dev) != hipSuccess || hipDeviceGetAttribute(&cus, hipDeviceAttributeMultiprocessorCount, dev) != hipSuccess) { grid = -1; return; }
        bool ok = true;
#if SINGLE_LAUNCH
        ok = (hipFuncSetAttribute((const void*)mk_fwd<0x1FFFu>, hipFuncAttributeMaxDynamicSharedMemorySize, LDS_BYTES) == hipSuccess);
#else
#define SETA(k) ok = ok && (hipFuncSetAttribute((const void*)mk_fwd<(1u << k)>, hipFuncAttributeMaxDynamicSharedMemorySize, LDS_BYTES) == hipSuccess)
        SETA(0); SETA(1); SETA(2); SETA(3); SETA(4); SETA(5); SETA(6); SETA(7); SETA(8); SETA(9); SETA(10); SETA(11); SETA(12);
#undef SETA
#endif
        if (!ok) { grid = -1; return; }
        grid = cus;
    }
    if (grid < 0 || n_in != 28 || ws_size < WS_END) return;
    float* out = (float*)d_out;
    char* ws = (char*)d_ws;

    (void)hipMemsetAsync(ws + WS_CTL, 0, CTL_ZERO_BYTES, stream);
    Args a{};
    for (int i = 0; i < 28; ++i) a.in[i] = (const float*)d_in[i];
    a.out = out; a.ws = (unsigned char*)d_ws;
#if SINGLE_LAUNCH
    a.ph_lo = 0; a.ph_hi = NPHASE; hipLaunchKernelGGL(mk_fwd<0x1FFFu>, dim3(grid), dim3(NWAVES * 64), LDS_BYTES, stream, a);
#else
#define LAUNCH(k) do { a.ph_lo = k; a.ph_hi = k + 1; hipLaunchKernelGGL(mk_fwd<(1u << k)>, dim3(grid), dim3(NWAVES * 64), LDS_BYTES, stream, a); } while (0)
    LAUNCH(0); LAUNCH(1); LAUNCH(2); LAUNCH(3); LAUNCH(4); LAUNCH(5); LAUNCH(6); LAUNCH(7); LAUNCH(8); LAUNCH(9); LAUNCH(10); LAUNCH(11); LAUNCH(12);
#undef LAUNCH
#endif

}
```
